# Optimizing an MI355X kernel written in HIP

```python
import jax, jax.numpy as jnp
from jax import lax
import numpy as np

D_MODEL = 1024
BATCH = 1
SEQ = 16384
DEPTH = 4

GRID_W = 64
CTX_LEN = 256
N_MIXERS = 3
N_MOD = 9
D_FF = 2816
FFN_RES = 0.5
NORM_EPS = 1e-6

RW_HEAD = 64
RW_HEADS = D_MODEL // RW_HEAD
RW_DECAY_LORA = 64
RW_ICLR_LORA = 64
RW_VALUE_LORA = 32
RW_GATE_LORA = 160
RW_GN_EPS = 64e-5

MLA_HEADS = 16
MLA_NOPE = 64
MLA_ROPE = 32
MLA_V = 64
MLA_Q_RANK = 384
MLA_KV_RANK = 256
ROPE_BASE = 10000.0
Q_BLOCK = 128

POOL_WINDOWS = (2, 4, 8, 16)
POOL_GROUP = D_MODEL // len(POOL_WINDOWS)

N_RWKV = (DEPTH + 2) // 3
N_RWKV_VRES = N_RWKV - 1
N_MLA = (DEPTH + 1) // 3
N_POOL = DEPTH // 3

kernel_name = 'hybrid_rwkv7_mla_pool_dit_trunk'


def _rms(x, g, eps=NORM_EPS):
    xf = x.astype(jnp.float32)
    y = xf * lax.rsqrt(jnp.mean(xf * xf, axis=-1, keepdims=True) + eps)
    return (y * g.astype(jnp.float32)).astype(x.dtype)


def _swiglu(h, wg, wu, wd):
    return (jax.nn.silu(h @ wg) * (h @ wu)) @ wd


def _pre(s, mod, slot, g_pre):
    return _rms(s, g_pre) * (1 + mod[:, 3 * slot + 1]) + mod[:, 3 * slot]


def _post(s, y, mod, slot, g_post, weight):
    return s + weight * mod[:, 3 * slot + 2] * _rms(y, g_post)


def _ffn_sublayer(s, mod, slot, g_pre, g_post, wg, wu, wd):
    return _post(s, _swiglu(_pre(s, mod, slot, g_pre), wg, wu, wd), mod, slot, g_post, FFN_RES)


def _axial_angles(rows):
    row = jnp.repeat(jnp.arange(rows, dtype=jnp.float32), GRID_W)
    col = jnp.tile(jnp.arange(GRID_W, dtype=jnp.float32), rows)
    axis_dim = MLA_ROPE // 2
    inv = ROPE_BASE ** (-jnp.arange(0, axis_dim, 2, dtype=jnp.float32) / axis_dim)
    return row[:, None] * inv, col[:, None] * inv


def _rotate_half(x, ang):
    shape = (1, ang.shape[0]) + (1,) * (x.ndim - 3) + (ang.shape[1],)
    cos = jnp.cos(ang).reshape(shape)
    sin = jnp.sin(ang).reshape(shape)
    x1, x2 = jnp.split(x.astype(jnp.float32), 2, axis=-1)
    return jnp.concatenate([x1 * cos - x2 * sin, x1 * sin + x2 * cos], axis=-1).astype(x.dtype)


def _axial_rope(x, ang_row, ang_col):
    half = x.shape[-1] // 2
    return jnp.concatenate([_rotate_half(x[..., :half], ang_row),
                            _rotate_half(x[..., half:], ang_col)], axis=-1)


def _heads(t):
    return t.reshape(t.shape[:-1] + (RW_HEADS, RW_HEAD))


def _rwkv_stream(h, p, v_first, readout):
    B, T, D = h.shape
    zero = jnp.zeros((B, 1, D), h.dtype)
    prev = jnp.concatenate([zero, h[:, :-1]], axis=1)
    nxt = jnp.concatenate([h[:, 1:], zero], axis=1)
    xx = 0.5 * (prev + nxt) - h
    mu = p['mu']
    xw, xk, xv, xa = (h + xx * mu[n] for n in (1, 2, 3, 4))
    k = xk @ p['w_k']
    v = xv @ p['w_v']
    if v_first is None:
        v_first = v
    else:
        v = v + (v_first - v) * jax.nn.sigmoid(p['v0'] + (xv @ p['v1']) @ p['v2'])
    kkf = _heads(k * p['k_k']).astype(jnp.float32)
    kk = kkf * lax.rsqrt(jnp.maximum(jnp.sum(kkf * kkf, -1, keepdims=True), 1e-24))
    dirs = []
    for d in range(2):
        lw = (p['w0'][d] + jnp.tanh(xw @ p['w1'][d]) @ p['w2'][d]).astype(jnp.float32)
        decay = jnp.exp(-jnp.exp(-jax.nn.softplus(-lw) - 0.5))
        a = jax.nn.sigmoid(p['a0'][d] + (xa @ p['a1'][d]) @ p['a2'][d])
        k_d = k * (1 + (a - 1) * p['k_a'])
        dirs.append((_heads(decay), _heads(a).astype(jnp.float32), _heads(k_d).astype(jnp.float32)))
    st = {'v': _heads(v).astype(jnp.float32), 'kk': kk, 'dirs': dirs}
    if readout:
        xr = h + xx * mu[0]
        xg = h + xx * mu[5]
        st['r'] = _heads(xr @ p['w_r']).astype(jnp.float32)
        st['g'] = jax.nn.sigmoid(xg @ p['g1']) @ p['g2']
    return st, v_first


def _wkv_scan(s0, decay, k, v, kk, a, r, reverse):
    emit = r is not None
    seq = (decay, k, v, kk, a) + ((r,) if emit else ())
    xs = tuple(jnp.moveaxis(t, 1, 0) for t in seq)

    def step(s, inp):
        w_t, k_t, v_t, kk_t, a_t = inp[:5]
        s_kk = jnp.einsum('bhvk,bhk->bhv', s, kk_t)
        s = (s * w_t[:, :, None, :]
             - s_kk[..., None] * (kk_t * a_t)[:, :, None, :]
             + v_t[..., None] * k_t[:, :, None, :])
        return s, (jnp.einsum('bhvk,bhk->bhv', s, inp[5]) if emit else None)

    s_fin, ys = lax.scan(step, s0, xs, reverse=reverse)
    return s_fin, (jnp.moveaxis(ys, 0, 1) if emit else None)


def _rwkv_readout(st, ys, p, out_dtype):
    r, v = st['r'], st['v']
    B, T = r.shape[:2]
    ln_w = p['ln_w'].astype(jnp.float32)
    ln_b = p['ln_b'].astype(jnp.float32)
    r_k = p['r_k'].astype(jnp.float32)
    o = jnp.zeros((B, T, D_MODEL), jnp.float32)
    for (_, _, k_d), y in zip(st['dirs'], ys):
        mu = jnp.mean(y, -1, keepdims=True)
        var = jnp.mean(jnp.square(y - mu), -1, keepdims=True)
        yn = ((y - mu) * lax.rsqrt(var + RW_GN_EPS)).reshape(B, T, D_MODEL) * ln_w + ln_b
        bonus = (jnp.sum(r * k_d * r_k, -1, keepdims=True) * v).reshape(B, T, D_MODEL)
        o = o + yn + bonus
    return (o.astype(out_dtype) * st['g']) @ p['w_o']


def _rwkv_mixer(hc, hx, vf_c, vf_x, p, need_ctx):
    st_c, vf_c = _rwkv_stream(hc, p, vf_c, need_ctx)
    st_x, vf_x = _rwkv_stream(hx, p, vf_x, True)
    B = hx.shape[0]
    ys_c, ys_x = [], []
    for d, reverse in enumerate((False, True)):
        s0 = jnp.zeros((B, RW_HEADS, RW_HEAD, RW_HEAD), jnp.float32)
        dc, ac, kc = st_c['dirs'][d]
        s_ctx, y_c = _wkv_scan(s0, dc, kc, st_c['v'], st_c['kk'], ac, st_c.get('r'), reverse)
        dx, ax, kx = st_x['dirs'][d]
        _, y_x = _wkv_scan(s_ctx, dx, kx, st_x['v'], st_x['kk'], ax, st_x['r'], reverse)
        ys_c.append(y_c)
        ys_x.append(y_x)
    yx = _rwkv_readout(st_x, ys_x, p, hx.dtype)
    yc = _rwkv_readout(st_c, ys_c, p, hc.dtype) if need_ctx else None
    return yc, yx, vf_c, vf_x


def _mla_project(h, w_dq, q_norm, w_uq, w_dkv, kv_norm, w_ukv):
    B, T, _ = h.shape
    q = (_rms(h @ w_dq, q_norm) @ w_uq).reshape(B, T, MLA_HEADS, MLA_NOPE + MLA_ROPE)
    ckv = h @ w_dkv
    kv = (_rms(ckv[..., :MLA_KV_RANK], kv_norm) @ w_ukv).reshape(B, T, MLA_HEADS, MLA_NOPE + MLA_V)
    return (q[..., :MLA_NOPE], q[..., MLA_NOPE:], kv[..., :MLA_NOPE],
            ckv[..., MLA_KV_RANK:], kv[..., MLA_NOPE:])


def _attend(q_nope, q_rope, k_nope, k_rope, v):
    scale = (MLA_NOPE + MLA_ROPE) ** -0.5
    s = (jnp.einsum('bqhd,bkhd->bhqk', q_nope, k_nope)
         + jnp.einsum('bqhr,bkr->bhqk', q_rope, k_rope))
    p = jax.nn.softmax(s.astype(jnp.float32) * scale, axis=-1).astype(v.dtype)
    return jnp.einsum('bhqk,bkhd->bqhd', p, v)


def _blocked_attend(q_nope, q_rope, k_nope, k_rope, v):
    B, T = q_nope.shape[:2]
    nblk = T // Q_BLOCK

    def to_blocks(t):
        return jnp.moveaxis(t.reshape((B, nblk, Q_BLOCK) + t.shape[2:]), 1, 0)

    o = lax.map(lambda qs: _attend(qs[0], qs[1], k_nope, k_rope, v),
                (to_blocks(q_nope), to_blocks(q_rope)))
    return jnp.moveaxis(o, 0, 1).reshape((B, T) + o.shape[3:])


def _mla_mixer(hc, hx, ang_row, ang_col, w_dq, q_norm, w_uq, w_dkv, kv_norm, w_ukv, w_o, need_ctx):
    qn_c, qr_c, kn_c, kr_c, v_c = _mla_project(hc, w_dq, q_norm, w_uq, w_dkv, kv_norm, w_ukv)
    qn_x, qr_x, kn_x, kr_x, v_x = _mla_project(hx, w_dq, q_norm, w_uq, w_dkv, kv_norm, w_ukv)
    qr_x = _axial_rope(qr_x, ang_row, ang_col)
    kr_x = _axial_rope(kr_x, ang_row, ang_col)
    kn = jnp.concatenate([kn_c, kn_x], axis=1)
    kr = jnp.concatenate([kr_c, kr_x], axis=1)
    vv = jnp.concatenate([v_c, v_x], axis=1)
    B, T, _ = hx.shape
    yx = _blocked_attend(qn_x, qr_x, kn, kr, vv).reshape(B, T, MLA_HEADS * MLA_V) @ w_o
    yc = None
    if need_ctx:
        yc = _attend(qn_c, qr_c, kn_c, kr_c, v_c).reshape(B, hc.shape[1], MLA_HEADS * MLA_V) @ w_o
    return yc, yx


def _pool_mixer(h, w, b, scale):
    B, T, D = h.shape
    hf = h.astype(jnp.float32)
    csum = jnp.concatenate([jnp.zeros((B, 1, D), jnp.float32), jnp.cumsum(hf, axis=1)], axis=1)
    t = jnp.arange(T)
    outs = []
    for gi, win in enumerate(POOL_WINDOWS):
        lo = jnp.clip(t - win // 2, 0, T)
        hi = jnp.clip(t + win // 2, 0, T)
        sl = slice(gi * POOL_GROUP, (gi + 1) * POOL_GROUP)
        cg = csum[..., sl]
        mean = (jnp.take(cg, hi, axis=1) - jnp.take(cg, lo, axis=1)) / (hi - lo).astype(jnp.float32)[None, :, None]
        diff = (mean - hf[..., sl]).astype(h.dtype)
        outs.append(diff @ w[gi] + b[gi])
    return jnp.concatenate(outs, axis=-1) * scale


def setup_inputs(seed: int = 0) -> dict:
    key = jax.random.key(seed)
    ks = iter(jax.random.split(key, 64))
    D, F, H, N = D_MODEL, D_FF, RW_HEADS, RW_HEAD

    def nrm(shape, scale=1.0):
        return scale * jax.random.normal(next(ks), shape, jnp.float32)

    def gain(shape):
        return 1.0 + nrm(shape, 0.05)

    return {
        'x': nrm((BATCH, SEQ, D)),
        'c': nrm((BATCH, D)),
        'ctx': nrm((BATCH, CTX_LEN, D)),
        'c_ctx': nrm((D,)),
        'mod_w': nrm((DEPTH, D, N_MOD * D), 0.5 * D ** -0.5),
        'mod_b': nrm((DEPTH, N_MOD * D), 0.02),
        'norm_pre': gain((DEPTH, 3, D)),
        'norm_post': gain((DEPTH, 3, D)),
        'ffn_w_gate': nrm((DEPTH, 2, D, F), D ** -0.5),
        'ffn_w_up': nrm((DEPTH, 2, D, F), D ** -0.5),
        'ffn_w_down': nrm((DEPTH, 2, F, D), F ** -0.5),
        'rw_mu': jax.random.uniform(next(ks), (N_RWKV, 6, D), jnp.float32),
        'rw_w_r': nrm((N_RWKV, D, D), D ** -0.5),
        'rw_w_k': nrm((N_RWKV, D, D), D ** -0.5),
        'rw_w_v': nrm((N_RWKV, D, D), D ** -0.5),
        'rw_w_o': nrm((N_RWKV, D, D), D ** -0.5),
        'rw_w0': nrm((N_RWKV, 2, D)) - 3.0,
        'rw_w1': nrm((N_RWKV, 2, D, RW_DECAY_LORA), D ** -0.5),
        'rw_w2': nrm((N_RWKV, 2, RW_DECAY_LORA, D), 0.5 * RW_DECAY_LORA ** -0.5),
        'rw_a0': nrm((N_RWKV, 2, D), 0.5),
        'rw_a1': nrm((N_RWKV, 2, D, RW_ICLR_LORA), D ** -0.5),
        'rw_a2': nrm((N_RWKV, 2, RW_ICLR_LORA, D), 0.5 * RW_ICLR_LORA ** -0.5),
        'rw_v0': nrm((N_RWKV_VRES, D), 0.5),
        'rw_v1': nrm((N_RWKV_VRES, D, RW_VALUE_LORA), D ** -0.5),
        'rw_v2': nrm((N_RWKV_VRES, RW_VALUE_LORA, D), 0.5 * RW_VALUE_LORA ** -0.5),
        'rw_g1': nrm((N_RWKV, D, RW_GATE_LORA), D ** -0.5),
        'rw_g2': nrm((N_RWKV, RW_GATE_LORA, D), RW_GATE_LORA ** -0.5),
        'rw_k_k': 0.85 + nrm((N_RWKV, D), 0.05),
        'rw_k_a': 1.0 + nrm((N_RWKV, D), 0.05),
        'rw_r_k': nrm((N_RWKV, H, N), 0.1),
        'rw_ln_w': gain((N_RWKV, D)),
        'rw_ln_b': nrm((N_RWKV, D), 0.01),
        'mla_w_dq': nrm((N_MLA, D, MLA_Q_RANK), D ** -0.5),
        'mla_q_norm': gain((N_MLA, MLA_Q_RANK)),
        'mla_w_uq': nrm((N_MLA, MLA_Q_RANK, MLA_HEADS * (MLA_NOPE + MLA_ROPE)), MLA_Q_RANK ** -0.5),
        'mla_w_dkv': nrm((N_MLA, D, MLA_KV_RANK + MLA_ROPE), D ** -0.5),
        'mla_kv_norm': gain((N_MLA, MLA_KV_RANK)),
        'mla_w_ukv': nrm((N_MLA, MLA_KV_RANK, MLA_HEADS * (MLA_NOPE + MLA_V)), MLA_KV_RANK ** -0.5),
        'mla_w_o': nrm((N_MLA, MLA_HEADS * MLA_V, D), (MLA_HEADS * MLA_V) ** -0.5),
        'pool_w': nrm((N_POOL, len(POOL_WINDOWS), POOL_GROUP, POOL_GROUP), POOL_GROUP ** -0.5),
        'pool_b': nrm((N_POOL, len(POOL_WINDOWS), POOL_GROUP), 0.01),
        'pool_scale': 1.0 + nrm((N_POOL, D), 0.1),
    }


def reference(x, c, ctx, c_ctx, mod_w, mod_b, norm_pre, norm_post, ffn_w_gate, ffn_w_up, ffn_w_down,
              rw_mu, rw_w_r, rw_w_k, rw_w_v, rw_w_o, rw_w0, rw_w1, rw_w2, rw_a0, rw_a1, rw_a2,
              rw_v0, rw_v1, rw_v2, rw_g1, rw_g2, rw_k_k, rw_k_a, rw_r_k, rw_ln_w, rw_ln_b,
              mla_w_dq, mla_q_norm, mla_w_uq, mla_w_dkv, mla_kv_norm, mla_w_ukv, mla_w_o,
              pool_w, pool_b, pool_scale):
    B, T, D = x.shape
    rows = T // GRID_W
    ang_row, ang_col = _axial_angles(rows)
    cs = ctx
    sc = jax.nn.silu(c)
    scc = jax.nn.silu(c_ctx)[None]
    vf_c = None
    vf_x = None
    for i in range(DEPTH):
        kind, j = i % N_MIXERS, i // N_MIXERS
        last = i == DEPTH - 1
        ctx_live = (not last) or kind != 2
        mod_x = (sc @ mod_w[i] + mod_b[i]).reshape(B, N_MOD, 1, D)
        mod_c = (scc @ mod_w[i] + mod_b[i]).reshape(1, N_MOD, 1, D)

        x = _ffn_sublayer(x, mod_x, 0, norm_pre[i, 0], norm_post[i, 0],
                          ffn_w_gate[i, 0], ffn_w_up[i, 0], ffn_w_down[i, 0])
        if ctx_live:
            cs = _ffn_sublayer(cs, mod_c, 0, norm_pre[i, 0], norm_post[i, 0],
                               ffn_w_gate[i, 0], ffn_w_up[i, 0], ffn_w_down[i, 0])

        hx = _pre(x, mod_x, 1, norm_pre[i, 1])
        hc = _pre(cs, mod_c, 1, norm_pre[i, 1]) if ctx_live else None
        if kind == 0:
            p = {'mu': rw_mu[j], 'w_r': rw_w_r[j], 'w_k': rw_w_k[j], 'w_v': rw_w_v[j], 'w_o': rw_w_o[j],
                 'w0': rw_w0[j], 'w1': rw_w1[j], 'w2': rw_w2[j],
                 'a0': rw_a0[j], 'a1': rw_a1[j], 'a2': rw_a2[j],
                 'g1': rw_g1[j], 'g2': rw_g2[j], 'k_k': rw_k_k[j], 'k_a': rw_k_a[j], 'r_k': rw_r_k[j],
                 'ln_w': rw_ln_w[j], 'ln_b': rw_ln_b[j]}
            if j > 0:
                p['v0'] = rw_v0[j - 1]
                p['v1'] = rw_v1[j - 1]
                p['v2'] = rw_v2[j - 1]
            yc, yx, vf_c, vf_x = _rwkv_mixer(hc, hx, vf_c, vf_x, p, not last)
        elif kind == 1:
            yc, yx = _mla_mixer(hc, hx, ang_row, ang_col, mla_w_dq[j], mla_q_norm[j], mla_w_uq[j],
                                mla_w_dkv[j], mla_kv_norm[j], mla_w_ukv[j], mla_w_o[j], not last)
        else:
            yx = _pool_mixer(hx, pool_w[j], pool_b[j], pool_scale[j])
            yc = _pool_mixer(hc, pool_w[j], pool_b[j], pool_scale[j]) if not last else None
        x = _post(x, yx, mod_x, 1, norm_post[i, 1], 1.0)

        x = _ffn_sublayer(x, mod_x, 2, norm_pre[i, 2], norm_post[i, 2],
                          ffn_w_gate[i, 1], ffn_w_up[i, 1], ffn_w_down[i, 1])
        if not last:
            cs = _post(cs, yc, mod_c, 1, norm_post[i, 1], 1.0)
            cs = _ffn_sublayer(cs, mod_c, 2, norm_pre[i, 2], norm_post[i, 2],
                               ffn_w_gate[i, 1], ffn_w_up[i, 1], ffn_w_down[i, 1])
    return x
```

```cpp
#include <hip/hip_runtime.h>
#include <hip/hip_cooperative_groups.h>
#include <cstdio>
namespace cg = cooperative_groups;

#define LAS __attribute__((address_space(3)))
#define DI __device__ __forceinline__
typedef unsigned short bf16_t;
typedef short bf16x8 __attribute__((ext_vector_type(8)));
typedef float f32x2 __attribute__((ext_vector_type(2)));
typedef float f32x4 __attribute__((ext_vector_type(4)));
typedef float f32x16 __attribute__((ext_vector_type(16)));
typedef unsigned u32x2 __attribute__((ext_vector_type(2)));
typedef unsigned u32x4 __attribute__((ext_vector_type(4)));

constexpr int D = 1024, FF = 2816, T = 16384, CL = 256, M = T + CL, DEPTH = 4;
constexpr int NT = 512;
constexpr float EPS = 1e-6f;
constexpr size_t MD2 = (size_t)M * D * 2;
constexpr size_t MD4 = (size_t)M * D * 4;

constexpr size_t SZ_MOD = (size_t)DEPTH * 2 * 9 * D * 4;
constexpr size_t SZ_SQ = (size_t)D * D * 2;
constexpr size_t SZ_W1 = (size_t)256 * D * 2;
constexpr size_t SZ_W2A = (size_t)4096 * 256 * 2, SZ_W2B = (size_t)2048 * 256 * 2;
constexpr size_t RWB_WR = 0, RWB_WK = SZ_SQ, RWB_WV = 2 * SZ_SQ, RWB_WO = 3 * SZ_SQ, RWB_W1W = 4 * SZ_SQ, RWB_W1A = RWB_W1W + SZ_W1, RWB_W1G = RWB_W1A + SZ_W1,
                 RWB_W1V = RWB_W1G + SZ_W1, RWB_W2A = RWB_W1V + SZ_W1, RWB_W2B = RWB_W2A + SZ_W2A, SZ_RWB = RWB_W2B + SZ_W2B;
constexpr size_t SZ_WD = (size_t)768 * D * 2, SZ_WUQ = (size_t)1536 * 384 * 2, SZ_WUKV = (size_t)2048 * 256 * 2;
constexpr size_t SZ_FFN1 = (size_t)2 * FF * D * 2, SZ_FFN2 = (size_t)D * FF * 2, SZ_FFNS = SZ_FFN1 + SZ_FFN2;
constexpr size_t OFF_MOD = 0;
constexpr size_t OFF_RWB = OFF_MOD + SZ_MOD;
constexpr size_t OFF_MLA = OFF_RWB + 2 * SZ_RWB;
constexpr size_t OFF_POOLW = OFF_MLA + SZ_WD + SZ_WUQ + SZ_WUKV + SZ_SQ;
constexpr size_t OFF_FFN = OFF_POOLW + SZ_SQ;
constexpr size_t OFF_S = OFF_FFN + 2 * SZ_FFNS;
constexpr size_t OFF_VF = OFF_S + MD4;
constexpr size_t OFF_Y = OFF_VF + MD2;
constexpr size_t OFF_H = OFF_Y + MD4;
constexpr size_t OFF_X = OFF_H + MD2;
constexpr size_t OFF_RKV = OFF_X + 6 * MD2;
constexpr size_t OFF_Y1C = OFF_RKV + 3 * MD2;
constexpr size_t OFF_BAR = OFF_Y1C + (size_t)CL * D * 4;
constexpr size_t WS_TOTAL = OFF_BAR + 16384;
constexpr size_t OFF_CQN = OFF_X, OFF_CKVN = OFF_CQN + (size_t)M * 384 * 2, OFF_KR = OFF_CKVN + (size_t)M * 256 * 2, OFF_Q = OFF_KR + (size_t)M * 32 * 4,
                 OFF_KV = OFF_Q + (size_t)M * 1536 * 2, OFF_KP = OFF_KV + (size_t)M * 2048 * 2, OFF_VT = OFF_KP + (size_t)M * 1536 * 2, OFF_MLA_END = OFF_VT + MD2;
static_assert(OFF_MLA_END <= OFF_Y1C, "mla scratch");
static_assert((size_t)M * FF * 2 <= 6 * MD2, "act scratch");
static_assert(OFF_X % 256 == 0 && OFF_FFN % 256 == 0 && OFF_S % 256 == 0, "align");

struct Params { const float* in[42]; float* out; unsigned char* ws; };
struct Ctx {
    const LAS unsigned* tab;
    DI unsigned long long q(int i) const { const unsigned lo = __builtin_amdgcn_readfirstlane(tab[2 * i]), hi = __builtin_amdgcn_readfirstlane(tab[2 * i + 1]); return ((unsigned long long)hi << 32) | lo; }
    DI const float* in(int i) const { return (const float*)(const __attribute__((address_space(1))) float*)q(i); }
    DI float* out() const { return (float*)(__attribute__((address_space(1))) float*)q(42); }
    DI unsigned char* ws() const { return (unsigned char*)(__attribute__((address_space(1))) unsigned char*)q(43); }
};

DI int otid() { int t = threadIdx.x; asm volatile("" : "+v"(t)); return t; }
DI float bf2f(bf16_t b) { return __uint_as_float((unsigned)b << 16); }
DI unsigned cvt_pk_bf16(float lo, float hi) { unsigned r; asm volatile("s_nop 1\n\tv_cvt_pk_bf16_f32 %0, %1, %2" : "=v"(r) : "v"(lo), "v"(hi)); return r; }
DI bf16_t f2bf(float f) { return (bf16_t)(cvt_pk_bf16(f, 0.f) & 0xffffu); }
DI float sigmoidf_(float x) { return __builtin_amdgcn_rcpf(1.0f + __builtin_amdgcn_exp2f(x * -1.4426950408889634f)); }
DI float tanhf_(float x) { return 1.0f - 2.0f * __builtin_amdgcn_rcpf(1.0f + __builtin_amdgcn_exp2f(x * 2.8853900817779268f)); }
DI float dpp_f(float x, const int ctrl_sel) {
    int xi = __builtin_bit_cast(int, x), r;
    if (ctrl_sel == 0) r = __builtin_amdgcn_update_dpp(0, xi, 0xB1, 0xF, 0xF, true);
    else if (ctrl_sel == 1) r = __builtin_amdgcn_update_dpp(0, xi, 0x4E, 0xF, 0xF, true);
    else if (ctrl_sel == 2) r = __builtin_amdgcn_update_dpp(0, xi, 0x141, 0xF, 0xF, true);
    else r = __builtin_amdgcn_update_dpp(0, xi, 0x140, 0xF, 0xF, true);
    return __builtin_bit_cast(float, r);
}
DI float red8(float v) { v += dpp_f(v, 0); v += dpp_f(v, 1); v += dpp_f(v, 2); return v; }
DI float red16(float v) { v += dpp_f(v, 0); v += dpp_f(v, 1); v += dpp_f(v, 2); v += dpp_f(v, 3); return v; }
DI float wave_sum(float v) {
    v = red16(v);
    { const unsigned x = __builtin_bit_cast(unsigned, v); auto pr = __builtin_amdgcn_permlane16_swap(x, x, false, false); v = __builtin_bit_cast(float, (unsigned)pr[0]) + __builtin_bit_cast(float, (unsigned)pr[1]); }
    { const unsigned x = __builtin_bit_cast(unsigned, v); auto pr = __builtin_amdgcn_permlane32_swap(x, x, false, false); v = __builtin_bit_cast(float, (unsigned)pr[0]) + __builtin_bit_cast(float, (unsigned)pr[1]); }
    return v;
}
DI void unpack8(const u32x4 w, float* f) {
    f[0] = __uint_as_float(w.x << 16); f[1] = __uint_as_float(w.x & 0xffff0000u); f[2] = __uint_as_float(w.y << 16); f[3] = __uint_as_float(w.y & 0xffff0000u);
    f[4] = __uint_as_float(w.z << 16); f[5] = __uint_as_float(w.z & 0xffff0000u); f[6] = __uint_as_float(w.w << 16); f[7] = __uint_as_float(w.w & 0xffff0000u);
}


#define XB_TMO      128
#define XB_XCNT(j)  (256  + 64 * (j))
#define XB_XSUB(j)  (1280 + 64 * (j))
#define XB_XGEN(j)  (2304 + 64 * (j))
#define XB_TOP      3328
#define XB_TOPGEN   3392
#define XCD_BAR_WORDS 3456
#define XB_SPIN_CAP (1u << 25)
DI unsigned xb_ld(unsigned* p)              { return __hip_atomic_load(p, __ATOMIC_RELAXED, __HIP_MEMORY_SCOPE_AGENT); }
DI unsigned xb_add(unsigned* p, unsigned v) { return __hip_atomic_fetch_add(p, v, __ATOMIC_RELAXED, __HIP_MEMORY_SCOPE_AGENT); }
DI unsigned xb_xcc_id() { return (unsigned)__builtin_amdgcn_s_getreg((3 << 11) | 20) & 0xFu; }
#define XB_SPIN(cond, bar) do { unsigned _sp = 0; while (cond) { __builtin_amdgcn_s_sleep(1); \
    if ((++_sp & 255u) == 0u) { if (xb_ld(&(bar)[XB_TMO])) break; if (_sp > XB_SPIN_CAP) { atomicAdd(&(bar)[XB_TMO], 1u); break; } } } } while (0)
struct XcdBarrier { unsigned* bar; unsigned x; volatile LAS unsigned* st; };
DI XcdBarrier xcd_barrier_post(unsigned* bar, volatile LAS unsigned* st) {
    XcdBarrier b; b.bar = bar; b.x = xb_xcc_id(); b.st = st;
    if (threadIdx.x == 0) (void)xb_add(&bar[XB_XCNT(b.x)], 1u);
    return b;
}
DI void xcd_barrier_complete(unsigned* bar, unsigned x, unsigned& nloc, unsigned& nx) {
    const unsigned G = gridDim.x * gridDim.y * gridDim.z;
    unsigned sum, cnt, mine, sp = 0u;
    for (;;) {
        sum = 0u; cnt = 0u; mine = 0u;
#pragma unroll
        for (unsigned j = 0; j < 16; ++j) { const unsigned c = xb_ld(&bar[XB_XCNT(j)]); sum += c; cnt += (c > 0u) ? 1u : 0u; mine = (j == x) ? c : mine; }
        if (sum == G) break;
        __builtin_amdgcn_s_sleep(1);
        if ((++sp & 255u) == 0u) { if (xb_ld(&bar[XB_TMO])) break; if (sp > XB_SPIN_CAP) { atomicAdd(&bar[XB_TMO], 1u); break; } }
    }
    nloc = mine > 0u ? mine : 1u; nx = cnt > 0u ? cnt : 1u;
}
DI void xcd_barrier(const XcdBarrier& b) {
    asm volatile("s_waitcnt vmcnt(0)" ::: "memory");
    __syncthreads();
    if (threadIdx.x == 0) {
        unsigned* bar = b.bar;
        __builtin_amdgcn_s_waitcnt(0);
        unsigned nloc = b.st[0], nx = b.st[1];
        if (nloc == 0u) { xcd_barrier_complete(bar, b.x, nloc, nx); b.st[0] = nloc; b.st[1] = nx; }
        const unsigned old = xb_add(&bar[XB_XSUB(b.x)], 1u);
        const unsigned gen = old / nloc;
        if (old + 1u == (gen + 1u) * nloc) {
            __builtin_amdgcn_fence(__ATOMIC_RELEASE, "agent");
            asm volatile("s_waitcnt vmcnt(0)" ::: "memory");
            const unsigned og = xb_add(&bar[XB_TOP], 1u);
            const unsigned tg = og / nx;
            if (og + 1u == (tg + 1u) * nx) xb_add(&bar[XB_TOPGEN], 1u);
            else XB_SPIN(xb_ld(&bar[XB_TOPGEN]) == tg, bar);
            __builtin_amdgcn_fence(__ATOMIC_ACQUIRE, "agent");
            xb_add(&bar[XB_XGEN(b.x)], 1u);
            asm volatile("s_waitcnt vmcnt(0)" ::: "memory");
        } else {
            XB_SPIN(xb_ld(&bar[XB_XGEN(b.x)]) == gen, bar);
            __builtin_amdgcn_fence(__ATOMIC_ACQUIRE, "agent");
            asm volatile("s_waitcnt vmcnt(0)" ::: "memory");
        }
    }
    __syncthreads();
}

namespace pg8 {
constexpr int BM = 256, BK = 64, HALF = 128, HTB = HALF * BK * 2, STAGE_BYTES = 8 * HTB, NXCD = 8, WGM = 8;
DI int lds_byte(int r, int c) { const int st = (r >> 4) * 2 + (c >> 5), rr = r & 15, cc = c & 31, ob = rr * 64 + cc * 2; return st * 1024 + (ob ^ (((ob >> 9) & 1) << 5)); }
DI void stage_rc(int b, int& R, int& C) { const int st = b / 1024, sb = b % 1024, swz = sb ^ (((sb >> 9) & 1) << 5); R = (st >> 1) * 16 + swz / 64; C = (st & 1) * 32 + (swz % 64) / 2; }
DI int perm32(int rho) { const int n = rho >> 4, i = rho & 15; return 8 * (i >> 2) + 4 * n + (i & 3); }
struct Unit { int pm, pn; };
struct Gemm { const bf16_t* A; const bf16_t* Bt; int M, N, K, lda, ldb; };
struct StaticOrder {
    int nM, nN, nwg, G, c;
    DI void init(int M_, int N_, int G_, int c_) { nM = M_ / BM; nN = N_ / BM; nwg = nM * nN; G = G_; c = c_; }
    DI bool next(int i, Unit& u) const {
        const long L = (long)i * G + c; if (L >= nwg) return false;
        int wgid = (int)L; { const int q = nwg / NXCD, r = nwg % NXCD, xcd = wgid % NXCD, off = wgid / NXCD; wgid = (xcd < r ? xcd * (q + 1) : r * (q + 1) + (xcd - r) * q) + off; }
        const int nig = WGM * nN, gid = wgid / nig, fm = gid * WGM, gsz = (nM - fm) < WGM ? (nM - fm) : WGM;
        u.pm = fm + ((wgid % nig) % gsz); u.pn = (wgid % nig) / gsz; return true;
    }
};
template <class Epi>
DI void gemm_phase(LAS unsigned char* lds, const Gemm g, const StaticOrder& S, const Epi& E) {
    const int tid = otid(), wid = __builtin_amdgcn_readfirstlane(tid >> 6), lane = tid & 63, wr = wid >> 2, wc = wid & 3, fr = lane & 15, fq = lane >> 4;
    const int K = g.K, nt = K / BK;
    unsigned voffA[2], voffB[2];
#pragma unroll
    for (int i = 0; i < 2; ++i) { int R, C; stage_rc(tid * 16 + i * 8192, R, C); const int Rb = (R & ~31) + perm32(R & 31);
        voffA[i] = (unsigned)(R * g.lda + C) * 2u; voffB[i] = (unsigned)(Rb * g.ldb + C) * 2u; }
    const size_t kstep = (size_t)(BK * 2);
    const size_t hA = (size_t)HALF * g.lda * 2, hB = (size_t)HALF * g.ldb * 2;
    const size_t tA = 2 * hA, tB = 2 * hB;
    const unsigned ldsw = (unsigned)wid * 1024u;
    const int aoff = lds_byte(wr * 64 + fr, fq * 8), boff = lds_byte(wc * 32 + fr, fq * 8);
#define PG8_SA(b, h) (((b) * 2 + (h)) * HTB)
#define PG8_SB(b, h) ((4 + (b) * 2 + (h)) * HTB)
#define PG8_STAGE(bufoff, gbase, voff) do { _Pragma("unroll") for (int _i = 0; _i < 2; ++_i) \
        __builtin_amdgcn_global_load_lds((const unsigned*)((const char*)(gbase) + (voff)[_i]), (LAS unsigned*)(lds + (bufoff) + ldsw + _i * 8192), 16, 0, 0); } while (0)
#define PG8_LDA(dst, b, h) do { _Pragma("unroll") for (int m = 0; m < 4; ++m) _Pragma("unroll") for (int k = 0; k < 2; ++k) dst[m][k] = *(const LAS bf16x8*)(lds + PG8_SA(b, h) + aoff + m * 2048 + k * 1024); } while (0)
#define PG8_LDB(dst, b, h) do { _Pragma("unroll") for (int n = 0; n < 2; ++n) _Pragma("unroll") for (int k = 0; k < 2; ++k) dst[n][k] = *(const LAS bf16x8*)(lds + PG8_SB(b, h) + boff + n * 2048 + k * 1024); } while (0)
#define PG8_MMA(ai, bj, At, Bt) do { __builtin_amdgcn_s_setprio(1); _Pragma("unroll") for (int m = 0; m < 4; ++m) _Pragma("unroll") for (int n = 0; n < 2; ++n) _Pragma("unroll") for (int k = 0; k < 2; ++k) \
        acc[ai][bj][m][n] = __builtin_amdgcn_mfma_f32_16x16x32_bf16(Bt[n][k], At[m][k], acc[ai][bj][m][n], 0, 0, 0); __builtin_amdgcn_s_setprio(0); } while (0)
#define PG8_WAIT_V(n) asm volatile("s_waitcnt vmcnt(" #n ")" ::: "memory")
#define PG8_WAIT_L(n) asm volatile("s_waitcnt lgkmcnt(" #n ")" ::: "memory")
#define PG8_BAR __builtin_amdgcn_s_barrier()
#define PG8_SCHED __builtin_amdgcn_sched_barrier(0)
    Unit cur, nxt; int ui = 0;
    if (!S.next(0, cur)) return;
    f32x4 acc[2][2][4][2];
#pragma unroll
    for (int a = 0; a < 2; ++a)
#pragma unroll
        for (int b = 0; b < 2; ++b)
#pragma unroll
            for (int m = 0; m < 4; ++m)
#pragma unroll
                for (int n = 0; n < 2; ++n) acc[a][b][m][n] = (f32x4){0.f, 0.f, 0.f, 0.f};
    bf16x8 At[4][2], B0[2][2], B1[2][2];
    const char* cA = (const char*)g.A + (size_t)cur.pm * tA; const char* cB = (const char*)g.Bt + (size_t)cur.pn * tB;
    PG8_STAGE(PG8_SB(0, 0), cB, voffB); PG8_STAGE(PG8_SA(0, 0), cA, voffA); PG8_STAGE(PG8_SB(0, 1), cB + hB, voffB); PG8_STAGE(PG8_SA(0, 1), cA + hA, voffA);
    if (wr == 1) PG8_BAR;
    PG8_WAIT_V(4); PG8_BAR;
    PG8_STAGE(PG8_SB(1, 0), cB + kstep, voffB); PG8_STAGE(PG8_SA(1, 0), cA + kstep, voffA); PG8_STAGE(PG8_SB(1, 1), cB + hB + kstep, voffB);
    PG8_WAIT_V(6); PG8_BAR;
    for (;;) {
        const bool has_next = S.next(ui + 1, nxt);
        const char* nA = has_next ? (const char*)g.A + (size_t)nxt.pm * tA : cA; const char* nB = has_next ? (const char*)g.Bt + (size_t)nxt.pn * tB : cB;
        for (int t = 0; t < nt; t += 2) {
            const bool last = (t == nt - 2);
            const char* a1 = cA + (size_t)(t + 1) * kstep;
            const char* a2 = last ? nA : cA + (size_t)(t + 2) * kstep; const char* b2 = last ? nB : cB + (size_t)(t + 2) * kstep;
            const char* a3 = a2 + kstep; const char* b3 = b2 + kstep;
            PG8_LDB(B0, 0, 0); PG8_SCHED; PG8_LDA(At, 0, 0); PG8_STAGE(PG8_SA(1, 1), a1 + hA, voffA);
            PG8_WAIT_L(8); PG8_BAR; PG8_WAIT_L(0); PG8_MMA(0, 0, At, B0); PG8_BAR; PG8_SCHED;
            PG8_LDB(B1, 0, 1); PG8_STAGE(PG8_SB(0, 0), b2, voffB);
            PG8_BAR; PG8_WAIT_L(0); PG8_MMA(0, 1, At, B1); PG8_BAR;
            PG8_LDA(At, 0, 1); PG8_STAGE(PG8_SA(0, 0), a2, voffA);
            PG8_BAR; PG8_WAIT_L(0); PG8_MMA(1, 0, At, B0); PG8_BAR; PG8_SCHED;
            PG8_STAGE(PG8_SB(0, 1), b2 + hB, voffB);
            PG8_WAIT_V(6); PG8_BAR; PG8_MMA(1, 1, At, B1); PG8_BAR;
            PG8_LDB(B0, 1, 0); PG8_SCHED; PG8_LDA(At, 1, 0); PG8_STAGE(PG8_SA(0, 1), a2 + hA, voffA);
            PG8_WAIT_L(8); PG8_BAR; PG8_WAIT_L(0); PG8_MMA(0, 0, At, B0); PG8_BAR; PG8_SCHED;
            PG8_LDB(B1, 1, 1); PG8_STAGE(PG8_SB(1, 0), b3, voffB);
            PG8_BAR; PG8_WAIT_L(0); PG8_MMA(0, 1, At, B1); PG8_BAR;
            PG8_LDA(At, 1, 1); PG8_STAGE(PG8_SA(1, 0), a3, voffA);
            PG8_BAR; PG8_WAIT_L(0); PG8_MMA(1, 0, At, B0); PG8_BAR; PG8_SCHED;
            PG8_STAGE(PG8_SB(1, 1), b3 + hB, voffB);
            PG8_WAIT_V(6); PG8_BAR; PG8_MMA(1, 1, At, B1); PG8_BAR;
        }
        E(acc, cur, wr, wc, fr, fq);
        if (!has_next) break;
#pragma unroll
        for (int a = 0; a < 2; ++a)
#pragma unroll
            for (int b = 0; b < 2; ++b)
#pragma unroll
                for (int m = 0; m < 4; ++m)
#pragma unroll
                    for (int n = 0; n < 2; ++n) acc[a][b][m][n] = (f32x4){0.f, 0.f, 0.f, 0.f};
        cur = nxt; cA = nA; cB = nB; ++ui;
    }
    PG8_WAIT_V(0);
    if (wr == 0) PG8_BAR;
    PG8_BAR;
#undef PG8_SA
#undef PG8_SB
#undef PG8_STAGE
#undef PG8_LDA
#undef PG8_LDB
#undef PG8_MMA
#undef PG8_WAIT_V
#undef PG8_WAIT_L
#undef PG8_BAR
#undef PG8_SCHED
}

struct EpiF32 {
    float* C; int ldc;
    DI void operator()(const f32x4 (&acc)[2][2][4][2], const Unit& u, int wr, int wc, int fr, int fq) const {
        const int row0 = u.pm * BM + wr * 64 + fr, col0 = u.pn * BM + wc * 32 + 8 * fq;
#pragma unroll
        for (int ai = 0; ai < 2; ++ai)
#pragma unroll
            for (int m = 0; m < 4; ++m) { float* rowp = C + (size_t)(row0 + ai * HALF + m * 16) * ldc + col0;
#pragma unroll
                for (int bj = 0; bj < 2; ++bj) { *(f32x4*)(rowp + bj * HALF) = acc[ai][bj][m][0]; *(f32x4*)(rowp + bj * HALF + 4) = acc[ai][bj][m][1]; } }
    }
};
struct EpiPool {
    float* C; const float* bias; const float* scale;
    DI void operator()(const f32x4 (&acc)[2][2][4][2], const Unit& u, int wr, int wc, int fr, int fq) const {
        const int row0 = u.pm * BM + wr * 64 + fr, col0 = u.pn * BM + wc * 32 + 8 * fq;
#pragma unroll
        for (int bj = 0; bj < 2; ++bj) {
            const f32x4 b0 = *(const f32x4*)(bias + col0 + bj * HALF), b1 = *(const f32x4*)(bias + col0 + bj * HALF + 4);
            const f32x4 s0 = *(const f32x4*)(scale + col0 + bj * HALF), s1 = *(const f32x4*)(scale + col0 + bj * HALF + 4);
#pragma unroll
            for (int ai = 0; ai < 2; ++ai)
#pragma unroll
                for (int m = 0; m < 4; ++m) { float* rowp = C + (size_t)(row0 + ai * HALF + m * 16) * D + col0 + bj * HALF;
                    *(f32x4*)(rowp) = (acc[ai][bj][m][0] + b0) * s0; *(f32x4*)(rowp + 4) = (acc[ai][bj][m][1] + b1) * s1; } }
    }
};
struct EpiSwiglu {
    bf16_t* O;
    DI void operator()(const f32x4 (&acc)[2][2][4][2], const Unit& u, int wr, int wc, int fr, int fq) const {
        const int row0 = u.pm * BM + wr * 64 + fr, col0 = u.pn * HALF + wc * 32 + 8 * fq;
#pragma unroll
        for (int ai = 0; ai < 2; ++ai)
#pragma unroll
            for (int m = 0; m < 4; ++m) {
                float o[8];
#pragma unroll
                for (int n = 0; n < 2; ++n)
#pragma unroll
                    for (int j = 0; j < 4; ++j) { const float gv = acc[ai][0][m][n][j], uv = acc[ai][1][m][n][j]; o[n * 4 + j] = gv * sigmoidf_(gv) * uv; }
                u32x4 w; w.x = cvt_pk_bf16(o[0], o[1]); w.y = cvt_pk_bf16(o[2], o[3]); w.z = cvt_pk_bf16(o[4], o[5]); w.w = cvt_pk_bf16(o[6], o[7]);
                *(u32x4*)(O + (size_t)(row0 + ai * HALF + m * 16) * FF + col0) = w; }
    }
};
struct EpiB {
    bf16_t* O; int ldc, coloff, ncols, mode; const float* b0; const float* b1; size_t sstride;
    DI void operator()(const f32x4 (&acc)[2][2][4][2], const Unit& u, int wr, int wc, int fr, int fq) const {
        const int row0 = u.pm * BM + wr * 64 + fr;
#pragma unroll
        for (int bj = 0; bj < 2; ++bj) {
            const int c = u.pn * BM + bj * HALF + wc * 32 + 8 * fq;
            if (c >= ncols) continue;
            int act = mode; const float* bias = nullptr; bf16_t* dst = O + coloff + c;
            if (mode == 3) { const int buf = c >> 10, cc = c & 1023; act = buf < 2 ? 3 : 2; bias = buf < 2 ? b0 + c : b1 + (c - 2048); dst = O + (size_t)buf * sstride + cc; }
            else if (mode == 4) { const int buf = c >> 10, cc = c & 1023; act = buf ? 2 : 0; bias = buf ? b1 + cc : nullptr; dst = O + (size_t)(4 + buf) * sstride + cc; }
            f32x4 bv0 = (f32x4){0.f, 0.f, 0.f, 0.f}, bv1 = bv0;
            if (bias) { bv0 = *(const f32x4*)bias; bv1 = *(const f32x4*)(bias + 4); }
#pragma unroll
            for (int ai = 0; ai < 2; ++ai)
#pragma unroll
                for (int m = 0; m < 4; ++m) {
                    f32x4 v0 = acc[ai][bj][m][0] + bv0, v1 = acc[ai][bj][m][1] + bv1;
                    float o[8] = {v0[0], v0[1], v0[2], v0[3], v1[0], v1[1], v1[2], v1[3]};
                    if (act == 1) {
#pragma unroll
                        for (int j = 0; j < 8; ++j) o[j] = tanhf_(o[j]);
                    } else if (act == 2) {
#pragma unroll
                        for (int j = 0; j < 8; ++j) o[j] = sigmoidf_(o[j]);
                    } else if (act == 3) {
#pragma unroll
                        for (int j = 0; j < 8; ++j) o[j] = 0.60653066f * sigmoidf_(o[j]);
                    }
                    u32x4 w; w.x = cvt_pk_bf16(o[0], o[1]); w.y = cvt_pk_bf16(o[2], o[3]); w.z = cvt_pk_bf16(o[4], o[5]); w.w = cvt_pk_bf16(o[6], o[7]);
                    *(u32x4*)(dst + (size_t)(row0 + ai * HALF + m * 16) * ldc) = w; }
        }
    }
};
}

template <class Epi>
DI void run_gemm(LAS unsigned char* lds, const bf16_t* A, int lda, const bf16_t* Bt, int ldb, int Mr, int N, int K, const Epi& E, int& used) {
    const int G = gridDim.x;
    pg8::Gemm g{A, Bt, Mr, N, K, lda, ldb};
    pg8::StaticOrder S; S.init(Mr, N, G, (int)((blockIdx.x + G - (used % G)) % G));
    pg8::gemm_phase<Epi>(lds, g, S, E);
    used += S.nwg;
}


DI void ffn_down(LAS unsigned char* lds, const Ctx& p, const bf16_t* ACT, const bf16_t* W2, float* Y, bool with_ctx, int& used) {
    { pg8::EpiF32 E{Y, D}; run_gemm(lds, ACT, FF, W2, FF, T, D, FF, E, used); }
    if (with_ctx) {
        float* part = (float*)(p.ws() + OFF_RKV);
        for (int kc = 0; kc < 11; ++kc) { pg8::EpiF32 E{part + (size_t)kc * CL * D, D}; run_gemm(lds, ACT + (size_t)T * FF + kc * 256, FF, W2 + kc * 256, FF, CL, D, 256, E, used); }
    }
}

DI void conv_t(const float* __restrict__ src, int sld, bf16_t* __restrict__ dst, int dld, int N, int K, int& rot) {
    const int tid_ = otid(); const int NW = gridDim.x * 8, gw = blockIdx.x * 8 + (tid_ >> 6), lane = tid_ & 63;
    const int ntn = N >> 4, ntile = ntn * (K >> 5);
    for (int t = (gw + NW - (rot % NW)) % NW; t < ntile; t += NW) {
        const int tn = t % ntn, tk = t / ntn;
        const int n = tn * 16 + (lane & 15), k0 = tk * 32 + (lane >> 4) * 8;
        const float* s = src + (size_t)k0 * sld + n;
        float v[8];
#pragma unroll
        for (int j = 0; j < 8; ++j) v[j] = __builtin_nontemporal_load(s + (size_t)j * sld);
        u32x4 w; w.x = cvt_pk_bf16(v[0], v[1]); w.y = cvt_pk_bf16(v[2], v[3]); w.z = cvt_pk_bf16(v[4], v[5]); w.w = cvt_pk_bf16(v[6], v[7]);
        *(u32x4*)(dst + (size_t)n * dld + k0) = w;
    }
    rot += ntile;
}
DI void zblock(bf16_t* dst, int dld, int N, int K) {
    const int kc = K >> 3, tot = N * kc;
    for (int q = blockIdx.x * NT + otid(); q < tot; q += gridDim.x * NT) { const int n = q / kc, c = q % kc; *(u32x4*)(dst + (size_t)n * dld + c * 8) = (u32x4){0u, 0u, 0u, 0u}; }
}
DI void conv_ffn(const Ctx& p, int layer, int& rot) {
    for (int s = 0; s < 2; ++s) {
        const float* wg = p.in(8) + (size_t)(layer * 2 + s) * D * FF;
        const float* wu = p.in(9) + (size_t)(layer * 2 + s) * D * FF;
        const float* wd = p.in(10) + (size_t)(layer * 2 + s) * FF * D;
        bf16_t* w1 = (bf16_t*)(p.ws() + OFF_FFN + s * SZ_FFNS);
        bf16_t* w2 = (bf16_t*)(p.ws() + OFF_FFN + s * SZ_FFNS + SZ_FFN1);
        for (int pn = 0; pn < 22; ++pn) {
            conv_t(wg + pn * 128, FF, w1 + (size_t)(pn * 256) * D, D, 128, D, rot);
            conv_t(wu + pn * 128, FF, w1 + (size_t)(pn * 256 + 128) * D, D, 128, D, rot);
        }
        conv_t(wd, D, w2, FF, D, FF, rot);
    }
}
DI void conv_mixers(const Ctx& p, int& rot) {
    for (int j = 0; j < 2; ++j) {
        unsigned char* b = p.ws() + OFF_RWB + j * SZ_RWB;
        conv_t(p.in(12) + (size_t)j * D * D, D, (bf16_t*)(b + RWB_WR), D, D, D, rot);
        conv_t(p.in(13) + (size_t)j * D * D, D, (bf16_t*)(b + RWB_WK), D, D, D, rot);
        conv_t(p.in(14) + (size_t)j * D * D, D, (bf16_t*)(b + RWB_WV), D, D, D, rot);
        conv_t(p.in(15) + (size_t)j * D * D, D, (bf16_t*)(b + RWB_WO), D, D, D, rot);
        bf16_t* w1w = (bf16_t*)(b + RWB_W1W); bf16_t* w1a = (bf16_t*)(b + RWB_W1A); bf16_t* w1g = (bf16_t*)(b + RWB_W1G); bf16_t* w1v = (bf16_t*)(b + RWB_W1V);
        for (int d = 0; d < 2; ++d) {
            conv_t(p.in(17) + (size_t)(j * 2 + d) * D * 64, 64, w1w + (size_t)d * 64 * D, D, 64, D, rot);
            conv_t(p.in(20) + (size_t)(j * 2 + d) * D * 64, 64, w1a + (size_t)d * 64 * D, D, 64, D, rot);
        }
        zblock(w1w + (size_t)128 * D, D, 128, D); zblock(w1a + (size_t)128 * D, D, 128, D);
        conv_t(p.in(25) + (size_t)j * D * 160, 160, w1g, D, 160, D, rot);
        zblock(w1g + (size_t)160 * D, D, 96, D);
        if (j == 1) { conv_t(p.in(23), 32, w1v, D, 32, D, rot); zblock(w1v + (size_t)32 * D, D, 224, D); }
        bf16_t* w2a = (bf16_t*)(b + RWB_W2A); bf16_t* w2b = (bf16_t*)(b + RWB_W2B);
        for (int q = 0; q < 4; ++q) {
            const float* src = (q < 2 ? p.in(18) : p.in(21)) + (size_t)(j * 2 + (q & 1)) * 64 * D;
            conv_t(src, D, w2a + (size_t)(q * 1024) * 256 + q * 64, 256, D, 64, rot);
            for (int z = 0; z < 4; ++z) if (z != q) zblock(w2a + (size_t)(q * 1024) * 256 + z * 64, 256, D, 64);
        }
        conv_t(p.in(26) + (size_t)j * 160 * D, D, w2b, 256, D, 160, rot);
        zblock(w2b + 160, 256, D, 96);
        if (j == 1) { conv_t(p.in(24), D, w2b + (size_t)1024 * 256 + 160, 256, D, 32, rot); zblock(w2b + (size_t)1024 * 256, 256, D, 160); zblock(w2b + (size_t)1024 * 256 + 192, 256, D, 64); }
    }
    {
        bf16_t* wd = (bf16_t*)(p.ws() + OFF_MLA); bf16_t* wuq = (bf16_t*)(p.ws() + OFF_MLA + SZ_WD); bf16_t* wukv = (bf16_t*)(p.ws() + OFF_MLA + SZ_WD + SZ_WUQ); bf16_t* wo = (bf16_t*)(p.ws() + OFF_MLA + SZ_WD + SZ_WUQ + SZ_WUKV);
        conv_t(p.in(32), 384, wd, D, 384, D, rot);
        conv_t(p.in(35), 288, wd + (size_t)384 * D, D, 288, D, rot);
        zblock(wd + (size_t)672 * D, D, 96, D);
        conv_t(p.in(34), 1536, wuq, 384, 1536, 384, rot);
        conv_t(p.in(37), 2048, wukv, 256, 2048, 256, rot);
        conv_t(p.in(38), D, wo, D, D, D, rot);
    }
    {
        bf16_t* wp = (bf16_t*)(p.ws() + OFF_POOLW);
        for (int g = 0; g < 4; ++g) for (int h = 0; h < 4; ++h) {
            if (g == h) conv_t(p.in(39) + (size_t)g * 256 * 256, 256, wp + (size_t)(g * 256) * D + g * 256, D, 256, 256, rot);
            else zblock(wp + (size_t)(g * 256) * D + h * 256, D, 256, 256);
        }
    }
}

DI void mod_phase(const Ctx& p, LAS unsigned char* lds) {
    LAS float* red = (LAS float*)lds;
    const int tid = otid(), wid = tid >> 6, lane = tid & 63;
    float* MOD = (float*)(p.ws() + OFF_MOD);
    for (int item = blockIdx.x; item < DEPTH * 36; item += gridDim.x) {
        const int layer = item / 36, cg_ = item % 36;
        const float* W = p.in(4) + (size_t)layer * D * 9 * D + cg_ * 256 + lane * 4;
        f32x4 a0 = (f32x4){0.f, 0.f, 0.f, 0.f}, a1 = a0;
        for (int k = wid * 128; k < wid * 128 + 128; ++k) {
            const float c0 = p.in(1)[k], c1 = p.in(3)[k];
            const float s0 = c0 * sigmoidf_(c0), s1 = c1 * sigmoidf_(c1);
            const f32x4 w = __builtin_nontemporal_load((const f32x4*)(W + (size_t)k * 9 * D));
            a0 += w * s0; a1 += w * s1;
        }
        *(LAS f32x4*)(red + (wid * 2 + 0) * 256 + lane * 4) = a0;
        *(LAS f32x4*)(red + (wid * 2 + 1) * 256 + lane * 4) = a1;
        __syncthreads();
        { const int s = tid >> 8, cc = tid & 255; float v = p.in(5)[layer * 9 * D + cg_ * 256 + cc];
#pragma unroll
          for (int w = 0; w < 8; ++w) v += red[(w * 2 + s) * 256 + cc];
          MOD[(size_t)(layer * 2 + s) * 9 * D + cg_ * 256 + cc] = v; }
        __syncthreads();
    }
}

DI void pp_load(const Ctx& p, int slotp, bool ypart, int r, int lane, f32x4 (&s)[4], f32x4 (&y)[4]) {
    const int st = r >= T ? 1 : 0;
    if (slotp < 0) {
        const float* src = st ? p.in(2) + (size_t)(r - T) * D : p.in(0) + (size_t)r * D;
#pragma unroll
        for (int i = 0; i < 4; ++i) { s[i] = *(const f32x4*)(src + i * 256 + lane * 4); y[i] = s[i]; }
    } else {
        const float* S = (const float*)(p.ws() + OFF_S); const float* Y = (const float*)(p.ws() + OFF_Y);
#pragma unroll
        for (int i = 0; i < 4; ++i) { s[i] = __builtin_nontemporal_load((const f32x4*)(S + (size_t)r * D + i * 256 + lane * 4));
            if (ypart && st) { const float* pp = (const float*)(p.ws() + OFF_RKV) + (size_t)(r - T) * D + i * 256 + lane * 4; f32x4 a = *(const f32x4*)pp;
#pragma unroll
                for (int kc = 1; kc < 11; ++kc) a += *(const f32x4*)(pp + (size_t)kc * CL * D);
                y[i] = a; }
            else y[i] = *(const f32x4*)(Y + (size_t)r * D + i * 256 + lane * 4); }
    }
}
DI void pp_proc(const Ctx& p, int lp, int slotp, float wgt, int lq, int slotq, bool hf32, bool fin, int r, int lane, f32x4 (&s)[4], const f32x4 (&y)[4]) {
    const int st = r >= T ? 1 : 0;
    float* S = (float*)(p.ws() + OFF_S); float* Y = (float*)(p.ws() + OFF_Y); bf16_t* H = (bf16_t*)(p.ws() + OFF_H);
    const float* MOD = (const float*)(p.ws() + OFF_MOD);
    if (slotp >= 0) {
        float ss = 0.f;
#pragma unroll
        for (int i = 0; i < 4; ++i) ss += y[i][0] * y[i][0] + y[i][1] * y[i][1] + y[i][2] * y[i][2] + y[i][3] * y[i][3];
        ss = wave_sum(ss);
        const float rs = rsqrtf(ss * (1.0f / D) + EPS) * wgt;
        const float* gate = MOD + (size_t)((lp * 2 + st) * 9 + 3 * slotp + 2) * D;
        const float* gp = p.in(7) + (size_t)(lp * 3 + slotp) * D;
#pragma unroll
        for (int i = 0; i < 4; ++i) { const f32x4 gt = *(const f32x4*)(gate + i * 256 + lane * 4), gg = *(const f32x4*)(gp + i * 256 + lane * 4); s[i] += gt * (y[i] * rs * gg); }
    }
    if (fin) {
#pragma unroll
        for (int i = 0; i < 4; ++i) *(f32x4*)(p.out() + (size_t)r * D + i * 256 + lane * 4) = s[i];
    } else {
#pragma unroll
        for (int i = 0; i < 4; ++i) __builtin_nontemporal_store(s[i], (f32x4*)(S + (size_t)r * D + i * 256 + lane * 4));
    }
    if (slotq >= 0) {
        float ss = 0.f;
#pragma unroll
        for (int i = 0; i < 4; ++i) ss += s[i][0] * s[i][0] + s[i][1] * s[i][1] + s[i][2] * s[i][2] + s[i][3] * s[i][3];
        ss = wave_sum(ss);
        const float rs = rsqrtf(ss * (1.0f / D) + EPS);
        const float* shift = MOD + (size_t)((lq * 2 + st) * 9 + 3 * slotq) * D;
        const float* scale = shift + D;
        const float* gq = p.in(6) + (size_t)(lq * 3 + slotq) * D;
#pragma unroll
        for (int i = 0; i < 4; ++i) {
            const f32x4 sh = *(const f32x4*)(shift + i * 256 + lane * 4), sc = *(const f32x4*)(scale + i * 256 + lane * 4), gg = *(const f32x4*)(gq + i * 256 + lane * 4);
            const f32x4 h = s[i] * rs * gg * (sc + 1.0f) + sh;
            if (hf32) *(f32x4*)(Y + (size_t)r * D + i * 256 + lane * 4) = h;
            else { u32x2 w; w.x = cvt_pk_bf16(h[0], h[1]); w.y = cvt_pk_bf16(h[2], h[3]); *(u32x2*)(H + (size_t)r * D + i * 256 + lane * 4) = w; }
        }
    }
}
DI void post_pre(const Ctx& p, int lp, int slotp, float wgt, int lq, int slotq, int nrows, bool hf32, bool fin, bool ypart) {
    const int tid_ = otid(); const int NW = gridDim.x * 8, gw = blockIdx.x * 8 + (tid_ >> 6), lane = tid_ & 63;
    for (int r = gw; r < nrows; r += 4 * NW) {
        const int r1 = r + NW, r2 = r + 2 * NW, r3 = r + 3 * NW;
        f32x4 s0[4], y0[4], s1[4], y1[4], s2[4], y2[4], s3[4], y3[4];
        pp_load(p, slotp, ypart, r, lane, s0, y0);
        if (r1 < nrows) pp_load(p, slotp, ypart, r1, lane, s1, y1);
        if (r2 < nrows) pp_load(p, slotp, ypart, r2, lane, s2, y2);
        if (r3 < nrows) pp_load(p, slotp, ypart, r3, lane, s3, y3);
        pp_proc(p, lp, slotp, wgt, lq, slotq, hf32, fin, r, lane, s0, y0);
        if (r1 < nrows) pp_proc(p, lp, slotp, wgt, lq, slotq, hf32, fin, r1, lane, s1, y1);
        if (r2 < nrows) pp_proc(p, lp, slotp, wgt, lq, slotq, hf32, fin, r2, lane, s2, y2);
        if (r3 < nrows) pp_proc(p, lp, slotp, wgt, lq, slotq, hf32, fin, r3, lane, s3, y3);
    }
}

DI void rwkv_mix(const Ctx& p, int j) {
    const int tid_ = otid(); const int NW = gridDim.x * 8, gw = blockIdx.x * 8 + (tid_ >> 6), lane = tid_ & 63;
    const float* Hf = (const float*)(p.ws() + OFF_Y);
    bf16_t* X = (bf16_t*)(p.ws() + OFF_X);
    bf16_t* L1b = (bf16_t*)(p.ws() + OFF_H) + (size_t)M * 256;
    const float* mu = p.in(11) + (size_t)j * 6 * D;
    for (int r = gw; r < M; r += NW) {
        const bool first = (r == 0) || (r == T), last = (r == T - 1) || (r == M - 1);
#pragma unroll
        for (int i = 0; i < 4; ++i) {
            const int c = i * 256 + lane * 4;
            const f32x4 h = *(const f32x4*)(Hf + (size_t)r * D + c);
            const f32x4 pv = first ? (f32x4){0.f, 0.f, 0.f, 0.f} : *(const f32x4*)(Hf + (size_t)(r - 1) * D + c);
            const f32x4 nx = last ? (f32x4){0.f, 0.f, 0.f, 0.f} : *(const f32x4*)(Hf + (size_t)(r + 1) * D + c);
            const f32x4 xx = (pv + nx) * 0.5f - h;
#pragma unroll
            for (int n = 0; n < 6; ++n) {
                const f32x4 m = *(const f32x4*)(mu + n * D + c);
                const f32x4 v = h + xx * m;
                u32x2 w; w.x = cvt_pk_bf16(v[0], v[1]); w.y = cvt_pk_bf16(v[2], v[3]);
                *(u32x2*)(X + (size_t)n * M * D + (size_t)r * D + c) = w;
            }
        }
        if (lane < 12) { unsigned z = 0u; asm volatile("" : "+v"(z)); *(u32x4*)(L1b + (size_t)r * 256 + 160 + lane * 8) = (u32x4){z, z, z, z}; }
    }
}

struct ScanA { const bf16_t* R; const bf16_t* K; const bf16_t* V; const bf16_t* VF; const bf16_t* VG; const bf16_t* Mw0; const bf16_t* Mw1; const bf16_t* Aa0; const bf16_t* Aa1;
               const float* kk_w; const float* ka_w; float* y0; float* y1x; float* y1c; int vres; int last; };
constexpr int SC_CH = 32, SC_STEP = 5 * 64 + 16, SC_BUF = SC_CH * SC_STEP, SC_YBUF = SC_CH * 128;
constexpr int SC_LDS_BYTES = (2 * SC_BUF + 2 * SC_YBUF) * 4;
DI int scan_row(int dir, int s) { return dir == 0 ? (s < CL ? T + s : s - CL) : (s < CL ? M - 1 - s : T - 1 - (s - CL)); }
struct ScanRaw { u32x4 k, a, m, r, v, vf, vg; };
template <bool VRES> DI void scan_load(const ScanA& A, int dir, int head, int chunk, int pt, ScanRaw& w) {
    const int row = scan_row(dir, chunk * SC_CH + (pt >> 3));
    const size_t off = (size_t)row * D + head * 64 + (pt & 7) * 8;
    w.k = *(const u32x4*)(A.K + off); w.a = *(const u32x4*)((dir ? A.Aa1 : A.Aa0) + off); w.m = *(const u32x4*)((dir ? A.Mw1 : A.Mw0) + off); w.r = *(const u32x4*)(A.R + off); w.v = *(const u32x4*)(A.V + off);
    if (VRES) { w.vf = *(const u32x4*)(A.VF + off); w.vg = *(const u32x4*)(A.VG + off); }
}
template <bool VRES> DI void scan_prep(const ScanA& A, const ScanRaw& w, const float* kkw, const float* kaw, LAS float* dst  , int kg, int vq) {
    float k[8], a[8], m[8], r[8], v[8];
    unpack8(w.k, k); unpack8(w.a, a); unpack8(w.m, m); unpack8(w.r, r); unpack8(w.v, v);
    if (VRES) { float vf[8], vg[8]; unpack8(w.vf, vf); unpack8(w.vg, vg);
#pragma unroll
        for (int j = 0; j < 8; ++j) v[j] = v[j] + (vf[j] - v[j]) * vg[j]; }
    float kk[8], ss = 0.f;
#pragma unroll
    for (int j = 0; j < 8; ++j) { kk[j] = k[j] * kkw[j]; ss += kk[j] * kk[j]; }
    ss = red8(ss);
    const float rn = rsqrtf(fmaxf(ss, 1e-24f));
    float o0[8], o1[8], o2[8];
#pragma unroll
    for (int j = 0; j < 8; ++j) { kk[j] *= rn; o0[j] = __expf(-m[j]); o1[j] = k[j] * (1.0f + (a[j] - 1.0f) * kaw[j]); o2[j] = kk[j] * a[j]; }
    LAS float* d8 = dst + kg * 8;
    *(LAS f32x4*)(d8 + 0 * 64) = (f32x4){o0[0], o0[1], o0[2], o0[3]}; *(LAS f32x4*)(d8 + 0 * 64 + 4) = (f32x4){o0[4], o0[5], o0[6], o0[7]};
    *(LAS f32x4*)(d8 + 1 * 64) = (f32x4){o1[0], o1[1], o1[2], o1[3]}; *(LAS f32x4*)(d8 + 1 * 64 + 4) = (f32x4){o1[4], o1[5], o1[6], o1[7]};
    *(LAS f32x4*)(d8 + 2 * 64) = (f32x4){o2[0], o2[1], o2[2], o2[3]}; *(LAS f32x4*)(d8 + 2 * 64 + 4) = (f32x4){o2[4], o2[5], o2[6], o2[7]};
    *(LAS f32x4*)(d8 + 3 * 64) = (f32x4){kk[0], kk[1], kk[2], kk[3]}; *(LAS f32x4*)(d8 + 3 * 64 + 4) = (f32x4){kk[4], kk[5], kk[6], kk[7]};
    *(LAS f32x4*)(d8 + 4 * 64) = (f32x4){r[0], r[1], r[2], r[3]};     *(LAS f32x4*)(d8 + 4 * 64 + 4) = (f32x4){r[4], r[5], r[6], r[7]};
    if (kg == vq) { LAS float* dv = dst + 320; *(LAS f32x4*)(dv) = (f32x4){v[0], v[1], v[2], v[3]}; *(LAS f32x4*)(dv + 4) = (f32x4){v[4], v[5], v[6], v[7]}; }
}
DI void scan_yreduce(const ScanA& A, const LAS float* yb, int dir, int head, int vq, int cc, int pt) {
    if (A.last && cc < CL / SC_CH) return;
    {
        const int q = pt, step = q >> 3, rowi = q & 7;
        const LAS float* src = yb + step * 128 + (rowi >> 2) * 64 + (rowi & 3) * 16;
        const f32x4 a0 = *(const LAS f32x4*)(src), a1 = *(const LAS f32x4*)(src + 4), a2 = *(const LAS f32x4*)(src + 8), a3 = *(const LAS f32x4*)(src + 12);
        const f32x4 t = (a0 + a1) + (a2 + a3);
        const float y = (t[0] + t[1]) + (t[2] + t[3]);
        const int row = scan_row(dir, cc * SC_CH + step);
        float* yp = dir == 0 ? A.y0 + (size_t)row * D : (row < T ? A.y1x + (size_t)row * D : A.y1c + (size_t)(row - T) * D);
        yp[head * 64 + vq * 8 + rowi] = y;
    }
}
#define SC_BAR() do { asm volatile("s_waitcnt lgkmcnt(0)" ::: "memory"); __builtin_amdgcn_s_barrier(); asm volatile("" ::: "memory"); } while (0)
template <bool VRES> DI void scan_phase(LAS unsigned char* lds, const ScanA& A) {
    if (blockIdx.x >= 256) return;
    const int wid = __builtin_amdgcn_readfirstlane(otid() >> 6);
    const int hd = blockIdx.x >> 3, head = hd & 15, dir = hd >> 4, vq = blockIdx.x & 7;
    LAS float* buf = (LAS float*)lds;
    LAS float* ybuf = buf + 2 * SC_BUF;
    constexpr int NCH = M / SC_CH;
    if (wid >= 4) {
        const int pt = otid() - 256, kg = pt & 7, stp = pt >> 3;
        float kkw[8], kaw[8];
#pragma unroll
        for (int j = 0; j < 8; ++j) { kkw[j] = A.kk_w[head * 64 + kg * 8 + j]; kaw[j] = A.ka_w[head * 64 + kg * 8 + j]; }
        ScanRaw S0, S1, S2;
        scan_load<VRES>(A, dir, head, 0, pt, S0);
        scan_prep<VRES>(A, S0, kkw, kaw, buf + stp * SC_STEP, kg, vq);
        scan_load<VRES>(A, dir, head, 1, pt, S1); scan_load<VRES>(A, dir, head, 2, pt, S2); scan_load<VRES>(A, dir, head, 3, pt, S0);
        SC_BAR();
#define SC_IT(c_, SET) do { const int c__ = (c_); \
            scan_prep<VRES>(A, SET, kkw, kaw, buf + ((c__ + 1) & 1) * SC_BUF + stp * SC_STEP, kg, vq); \
            scan_load<VRES>(A, dir, head, c__ + 4 < NCH ? c__ + 4 : NCH - 1, pt, SET); \
            if (c__ >= 1) scan_yreduce(A, ybuf + ((c__ - 1) & 1) * SC_YBUF, dir, head, vq, c__ - 1, pt); \
            SC_BAR(); } while (0)
        int c = 0;
        for (; c + 2 <= NCH; c += 3) { SC_IT(c, S1); SC_IT(c + 1, S2); SC_IT(c + 2, S0); }
        SC_IT(c, S1); SC_IT(c + 1, S2);
#undef SC_IT
    } else {
        const int lane = otid() & 63, vi = lane >> 4, kp = lane & 15;
        f32x2 sa = (f32x2){0.f, 0.f}, sb = (f32x2){0.f, 0.f};
        __builtin_amdgcn_s_setprio(2);
        SC_BAR();
        for (int c = 0; c <= NCH; ++c) {
            if (c < NCH && wid < 2) {
                const LAS float* b = buf + (c & 1) * SC_BUF + kp * 4;
                const LAS float* bv = buf + (c & 1) * SC_BUF + 320 + wid * 4 + vi;
                LAS float* yo = ybuf + (c & 1) * SC_YBUF + wid * 64 + lane;
                f32x4 w4 = *(const LAS f32x4*)(b + 0 * 64), kd4 = *(const LAS f32x4*)(b + 1 * 64), ka4 = *(const LAS f32x4*)(b + 2 * 64), kk4 = *(const LAS f32x4*)(b + 3 * 64), r4 = *(const LAS f32x4*)(b + 4 * 64);
                float vv = bv[0];
#pragma unroll
                for (int i = 0; i < SC_CH; ++i) {
                    const int in = i + 1 < SC_CH ? i + 1 : i;
                    const f32x4 nw4 = *(const LAS f32x4*)(b + in * SC_STEP + 0 * 64), nkd4 = *(const LAS f32x4*)(b + in * SC_STEP + 1 * 64), nka4 = *(const LAS f32x4*)(b + in * SC_STEP + 2 * 64),
                                nkk4 = *(const LAS f32x4*)(b + in * SC_STEP + 3 * 64), nr4 = *(const LAS f32x4*)(b + in * SC_STEP + 4 * 64);
                    const float nvv = bv[in * SC_STEP];
                    f32x2 t = sa * (f32x2){kk4[0], kk4[1]};
                    t = sb * (f32x2){kk4[2], kk4[3]} + t;
                    float d = t[0] + t[1];
                    d = red16(d);
                    sa = sa * (f32x2){w4[0], w4[1]} + (f32x2){kd4[0], kd4[1]} * vv;
                    sb = sb * (f32x2){w4[2], w4[3]} + (f32x2){kd4[2], kd4[3]} * vv;
                    sa = sa - (f32x2){ka4[0], ka4[1]} * d;
                    sb = sb - (f32x2){ka4[2], ka4[3]} * d;
                    f32x2 u = sa * (f32x2){r4[0], r4[1]};
                    u = sb * (f32x2){r4[2], r4[3]} + u;
                    yo[i * 128] = u[0] + u[1];
                    w4 = nw4; kd4 = nkd4; ka4 = nka4; kk4 = nkk4; r4 = nr4; vv = nvv;
                }
            }
            SC_BAR();
        }
        __builtin_amdgcn_s_setprio(0);
    }
}

DI void rwkv_readout(const Ctx& p, int j, int nrows, const ScanA& A, const bf16_t* Gg, bf16_t* O) {
    const int tid_ = otid(); const int NW = gridDim.x * 8, gw = blockIdx.x * 8 + (tid_ >> 6), lane = tid_ & 63;
    const int c0 = lane * 16;
    const float* lnw = p.in(30) + (size_t)j * D + c0; const float* lnb = p.in(31) + (size_t)j * D + c0; const float* rk = p.in(29) + (size_t)j * D + c0;
    for (int r = gw; r < nrows; r += NW) {
        const size_t off = (size_t)r * D + c0;
        float kf[16], rr[16], vv[16], o[16];
        unpack8(*(const u32x4*)(A.K + off), kf); unpack8(*(const u32x4*)(A.K + off + 8), kf + 8);
        unpack8(*(const u32x4*)(A.R + off), rr); unpack8(*(const u32x4*)(A.R + off + 8), rr + 8);
        unpack8(*(const u32x4*)(A.V + off), vv); unpack8(*(const u32x4*)(A.V + off + 8), vv + 8);
        if (A.vres) { float vf[16], vg[16];
            unpack8(*(const u32x4*)(A.VF + off), vf); unpack8(*(const u32x4*)(A.VF + off + 8), vf + 8);
            unpack8(*(const u32x4*)(A.VG + off), vg); unpack8(*(const u32x4*)(A.VG + off + 8), vg + 8);
#pragma unroll
            for (int q = 0; q < 16; ++q) vv[q] = vv[q] + (vf[q] - vv[q]) * vg[q]; }
#pragma unroll
        for (int q = 0; q < 16; ++q) o[q] = 0.f;
#pragma unroll
        for (int d = 0; d < 2; ++d) {
            const float* yp = d == 0 ? A.y0 + off : (r < T ? A.y1x + off : A.y1c + (size_t)(r - T) * D + c0);
            float y[16], a[16];
#pragma unroll
            for (int q = 0; q < 4; ++q) { const f32x4 t = *(const f32x4*)(yp + q * 4); y[q * 4] = t[0]; y[q * 4 + 1] = t[1]; y[q * 4 + 2] = t[2]; y[q * 4 + 3] = t[3]; }
            { const bf16_t* ap = d ? A.Aa1 : A.Aa0; unpack8(*(const u32x4*)(ap + off), a); unpack8(*(const u32x4*)(ap + off + 8), a + 8); }
            float sm = 0.f;
#pragma unroll
            for (int q = 0; q < 16; ++q) sm += y[q];
            sm += __shfl_xor(sm, 1); sm += __shfl_xor(sm, 2);
            const float mean = sm * (1.0f / 64.0f);
            float vs = 0.f, dot = 0.f;
#pragma unroll
            for (int q = 0; q < 16; ++q) { const float t = y[q] - mean; vs += t * t; const float kd = kf[q] * (1.0f + (a[q] - 1.0f) * p.in(28)[(size_t)j * D + c0 + q]); dot += rr[q] * kd * rk[q]; }
            vs += __shfl_xor(vs, 1); vs += __shfl_xor(vs, 2);
            dot += __shfl_xor(dot, 1); dot += __shfl_xor(dot, 2);
            const float rstd = rsqrtf(vs * (1.0f / 64.0f) + 64e-5f);
#pragma unroll
            for (int q = 0; q < 16; ++q) o[q] += (y[q] - mean) * rstd * lnw[q] + lnb[q] + dot * vv[q];
        }
        float g[16];
        unpack8(*(const u32x4*)(Gg + off), g); unpack8(*(const u32x4*)(Gg + off + 8), g + 8);
        u32x4 w0, w1;
        w0.x = cvt_pk_bf16(o[0] * g[0], o[1] * g[1]); w0.y = cvt_pk_bf16(o[2] * g[2], o[3] * g[3]); w0.z = cvt_pk_bf16(o[4] * g[4], o[5] * g[5]); w0.w = cvt_pk_bf16(o[6] * g[6], o[7] * g[7]);
        w1.x = cvt_pk_bf16(o[8] * g[8], o[9] * g[9]); w1.y = cvt_pk_bf16(o[10] * g[10], o[11] * g[11]); w1.z = cvt_pk_bf16(o[12] * g[12], o[13] * g[13]); w1.w = cvt_pk_bf16(o[14] * g[14], o[15] * g[15]);
        *(u32x4*)(O + off) = w0; *(u32x4*)(O + off + 8) = w1;
    }
}

DI float rope_inv(int j) { return exp2f(-(float)j * 1.6609640474436813f); }
DI void rope_cs(float pos, int j, float& cs, float& sn) { const float rev = pos * rope_inv(j) * 0.15915494309189535f; cs = __builtin_amdgcn_cosf(rev); sn = __builtin_amdgcn_sinf(rev); }
DI void mla_norms(const Ctx& p) {
    const int tid_ = otid(); const int NW = gridDim.x * 8, gw = blockIdx.x * 8 + (tid_ >> 6), lane = tid_ & 63;
    const float* C = (const float*)(p.ws() + OFF_Y);
    bf16_t* CQN = (bf16_t*)(p.ws() + OFF_CQN); bf16_t* CKVN = (bf16_t*)(p.ws() + OFF_CKVN); float* KR = (float*)(p.ws() + OFF_KR);
    for (int r = gw; r < M; r += NW) {
        const float* c = C + (size_t)r * 768;
        float q[6], ss = 0.f;
#pragma unroll
        for (int u = 0; u < 6; ++u) { q[u] = c[u * 64 + lane]; ss += q[u] * q[u]; }
        ss = wave_sum(ss);
        float rs = rsqrtf(ss * (1.0f / 384.0f) + EPS);
#pragma unroll
        for (int u = 0; u < 6; ++u) CQN[(size_t)r * 384 + u * 64 + lane] = f2bf(q[u] * rs * p.in(33)[u * 64 + lane]);
        float kv[4]; ss = 0.f;
#pragma unroll
        for (int u = 0; u < 4; ++u) { kv[u] = c[384 + u * 64 + lane]; ss += kv[u] * kv[u]; }
        ss = wave_sum(ss);
        rs = rsqrtf(ss * (1.0f / 256.0f) + EPS);
#pragma unroll
        for (int u = 0; u < 4; ++u) CKVN[(size_t)r * 256 + u * 64 + lane] = f2bf(kv[u] * rs * p.in(36)[u * 64 + lane]);
        const int d = lane & 31;
        const float v = c[640 + d];
        const float pr = __shfl_xor(v, 8);
        float o = v;
        if (r < T) {
            const int axis = d >> 4, jj = d & 15;
            const float pos = axis ? (float)(r & 63) : (float)(r >> 6);
            float cs, sn; rope_cs(pos, jj & 7, cs, sn);
            o = jj < 8 ? v * cs - pr * sn : pr * sn + v * cs;
        }
        if (lane < 32) KR[(size_t)r * 32 + d] = o;
    }
}
DI void mla_pack(const Ctx& p) {
    const int tid_ = otid(); const int NW = gridDim.x * 8, gw = blockIdx.x * 8 + (tid_ >> 6), lane = tid_ & 63;
    bf16_t* Q = (bf16_t*)(p.ws() + OFF_Q); const bf16_t* KV = (const bf16_t*)(p.ws() + OFF_KV); const float* KR = (const float*)(p.ws() + OFF_KR);
    bf16_t* KP = (bf16_t*)(p.ws() + OFF_KP); bf16_t* VT = (bf16_t*)(p.ws() + OFF_VT);
    const float qs = 0.10206207261596577f * 1.4426950408889634f;
    for (int r = gw; r < M; r += NW) {
        bf16_t* q = Q + (size_t)r * 1536; const bf16_t* kv = KV + (size_t)r * 2048; bf16_t* kp = KP + (size_t)r * 1536;
#pragma unroll 4
        for (int e = lane; e < 1024; e += 64) { const int h = e >> 6, d = e & 63; q[h * 96 + d] = f2bf(bf2f(q[h * 96 + d]) * qs); kp[h * 96 + d] = kv[h * 128 + d]; }
#pragma unroll 4
        for (int e = lane; e < 512; e += 64) { const int h = e >> 5, d = e & 31; kp[h * 96 + 64 + d] = f2bf(KR[(size_t)r * 32 + d]); }
        for (int pi = lane; pi < 256; pi += 64) {
            const int h = pi >> 4, axis = (pi >> 3) & 1, jj = pi & 7;
            bf16_t* a = q + h * 96 + 64 + axis * 16 + jj;
            const float x1 = bf2f(a[0]), x2 = bf2f(a[8]);
            float o1 = x1, o2 = x2;
            if (r < T) { const float pos = axis ? (float)(r & 63) : (float)(r >> 6); float cs, sn; rope_cs(pos, jj, cs, sn); o1 = x1 * cs - x2 * sn; o2 = x1 * sn + x2 * cs; }
            a[0] = f2bf(o1 * qs); a[8] = f2bf(o2 * qs);
        }
    }
    for (int it = gw; it < (M / 64) * 16; it += NW) {
        const int rb = it >> 4, h = it & 15, r0 = rb * 64;
        const bf16_t* src = KV + (size_t)r0 * 2048 + h * 128 + 64 + lane;
        bf16_t* dst = VT + (size_t)(h * 64 + lane) * M + r0;
#pragma unroll
        for (int g = 0; g < 8; ++g) {
            unsigned short v[8];
#pragma unroll
            for (int u = 0; u < 8; ++u) v[u] = src[(size_t)(g * 8 + u) * 2048];
            u32x4 w; w.x = v[0] | ((unsigned)v[1] << 16); w.y = v[2] | ((unsigned)v[3] << 16); w.z = v[4] | ((unsigned)v[5] << 16); w.w = v[6] | ((unsigned)v[7] << 16);
            *(u32x4*)(dst + g * 8) = w;
        }
    }
}

constexpr int AT_KS = 104, AT_VS = 68;
constexpr int AT_KBYTES = 64 * AT_KS * 2, AT_VBYTES = 64 * AT_VS * 2, AT_BUF = AT_KBYTES + AT_VBYTES;
DI bf16x8 pack_p(const f32x16& x, int s) {
    u32x4 pk;
    asm volatile("s_nop 1\n\tv_cvt_pk_bf16_f32 %0, %4, %5\n\tv_cvt_pk_bf16_f32 %1, %6, %7\n\tv_cvt_pk_bf16_f32 %2, %8, %9\n\tv_cvt_pk_bf16_f32 %3, %10, %11\n\ts_nop 1"
                 : "=&v"(pk[0]), "=&v"(pk[1]), "=&v"(pk[2]), "=&v"(pk[3])
                 : "v"(x[8 * s]), "v"(x[8 * s + 1]), "v"(x[8 * s + 2]), "v"(x[8 * s + 3]), "v"(x[8 * s + 4]), "v"(x[8 * s + 5]), "v"(x[8 * s + 6]), "v"(x[8 * s + 7]));
    return __builtin_bit_cast(bf16x8, pk);
}
DI void attn_phase(LAS unsigned char* lds, const Ctx& p) {
    const bf16_t* Qp = (const bf16_t*)(p.ws() + OFF_Q); const bf16_t* Kp = (const bf16_t*)(p.ws() + OFF_KP); const bf16_t* Vt = (const bf16_t*)(p.ws() + OFF_VT);
    bf16_t* AO = (bf16_t*)(p.ws() + OFF_H);
    const int tid = otid(), wid = tid >> 6, lane = tid & 63, l31 = lane & 31, hl = lane >> 5;
    for (int it = blockIdx.x; it < 1040; it += gridDim.x) {
        int h, qb;
        if (it < 1024) { const int rnd = it >> 8, bb = it & 255; h = (bb & 7) + 8 * (rnd & 1); qb = (bb >> 3) + 32 * (rnd >> 1); }
        else { h = it - 1024; qb = 64; }
        const int kb = qb == 64 ? T : 0, ntile = qb == 64 ? CL / 64 : M / 64;
        const int qrow = qb * 256 + wid * 32 + l31;
        bf16x8 qf[6];
#pragma unroll
        for (int st = 0; st < 6; ++st) qf[st] = *(const bf16x8*)(Qp + (size_t)qrow * 1536 + h * 96 + st * 16 + hl * 8);
        f32x16 o0, o1;
#pragma unroll
        for (int i = 0; i < 16; ++i) { o0[i] = 0.f; o1[i] = 0.f; }
        float mrun = 0.f, lsum = 0.f;
        f32x16 negm;
#pragma unroll
        for (int i = 0; i < 16; ++i) negm[i] = 0.f;
        const int kr0 = tid / 12, kc0 = tid % 12, kr1 = (tid + 512) / 12, kc1 = (tid + 512) % 12, vd = tid >> 3, vc = tid & 7;
        u32x4 gk0, gk1 = (u32x4){0u, 0u, 0u, 0u}, gv;
        {
            gk0 = *(const u32x4*)(Kp + (size_t)(kb + kr0) * 1536 + h * 96 + kc0 * 8);
            if (tid < 256) gk1 = *(const u32x4*)(Kp + (size_t)(kb + kr1) * 1536 + h * 96 + kc1 * 8);
            gv = *(const u32x4*)(Vt + (size_t)(h * 64 + vd) * M + kb + vc * 8);
            LAS unsigned char* b = lds;
            *(LAS u32x4*)(b + (kr0 * AT_KS + kc0 * 8) * 2) = gk0;
            if (tid < 256) *(LAS u32x4*)(b + (kr1 * AT_KS + kc1 * 8) * 2) = gk1;
            *(LAS u32x2*)(b + AT_KBYTES + (vd * AT_VS + vc * 8) * 2) = (u32x2){gv.x, gv.y};
            *(LAS u32x2*)(b + AT_KBYTES + (vd * AT_VS + vc * 8) * 2 + 8) = (u32x2){gv.z, gv.w};
        }
        __syncthreads();
        if (__builtin_amdgcn_readfirstlane(tid) >= 256) __builtin_amdgcn_s_setprio(1);
        for (int j = 0; j < ntile; ++j) {
            const bool more = j + 1 < ntile;
            if (more) {
                const int k0 = kb + (j + 1) * 64;
                gk0 = *(const u32x4*)(Kp + (size_t)(k0 + kr0) * 1536 + h * 96 + kc0 * 8);
                if (tid < 256) gk1 = *(const u32x4*)(Kp + (size_t)(k0 + kr1) * 1536 + h * 96 + kc1 * 8);
                gv = *(const u32x4*)(Vt + (size_t)(h * 64 + vd) * M + k0 + vc * 8);
            }
            const LAS unsigned char* kb_ = lds + (j & 1) * AT_BUF;
            const LAS unsigned char* vb_ = kb_ + AT_KBYTES;
            f32x16 s0, s1;
            {
                const bf16x8 a0 = *(const LAS bf16x8*)(kb_ + (l31 * AT_KS + hl * 8) * 2);
                const bf16x8 a1 = *(const LAS bf16x8*)(kb_ + ((32 + l31) * AT_KS + hl * 8) * 2);
                s0 = __builtin_amdgcn_mfma_f32_32x32x16_bf16(a0, qf[0], negm, 0, 0, 0);
                s1 = __builtin_amdgcn_mfma_f32_32x32x16_bf16(a1, qf[0], negm, 0, 0, 0);
            }
#pragma unroll
            for (int st = 1; st < 6; ++st) {
                const bf16x8 a0 = *(const LAS bf16x8*)(kb_ + (l31 * AT_KS + st * 16 + hl * 8) * 2);
                const bf16x8 a1 = *(const LAS bf16x8*)(kb_ + ((32 + l31) * AT_KS + st * 16 + hl * 8) * 2);
                s0 = __builtin_amdgcn_mfma_f32_32x32x16_bf16(a0, qf[st], s0, 0, 0, 0);
                s1 = __builtin_amdgcn_mfma_f32_32x32x16_bf16(a1, qf[st], s1, 0, 0, 0);
            }
            float mx = s0[0];
#pragma unroll
            for (int i = 1; i < 16; ++i) mx = fmaxf(mx, s0[i]);
#pragma unroll
            for (int i = 0; i < 16; ++i) mx = fmaxf(mx, s1[i]);
            mx = fmaxf(mx, __shfl_xor(mx, 32));
            if (__builtin_amdgcn_ballot_w64(mx > 8.0f) != 0ull) {
                const float delta = mx > 8.0f ? mx : 0.f;
                const float alpha = __builtin_amdgcn_exp2f(-delta);
                mrun += delta; lsum *= alpha;
#pragma unroll
                for (int i = 0; i < 16; ++i) { s0[i] -= delta; s1[i] -= delta; o0[i] *= alpha; o1[i] *= alpha; negm[i] = -mrun; }
            }
            float ps = 0.f;
#pragma unroll
            for (int i = 0; i < 16; ++i) { s0[i] = __builtin_amdgcn_exp2f(s0[i]); s1[i] = __builtin_amdgcn_exp2f(s1[i]); ps += s0[i] + s1[i]; }
            lsum += ps;
#pragma unroll
            for (int kt = 0; kt < 2; ++kt)
#pragma unroll
                for (int s = 0; s < 2; ++s) {
                    const bf16x8 pf = pack_p(kt ? s1 : s0, s);
                    const int kbase = kt * 32 + s * 16 + 4 * hl;
                    const u32x2 va0 = *(const LAS u32x2*)(vb_ + (l31 * AT_VS + kbase) * 2), va1 = *(const LAS u32x2*)(vb_ + (l31 * AT_VS + kbase + 8) * 2);
                    const u32x2 vb0 = *(const LAS u32x2*)(vb_ + ((32 + l31) * AT_VS + kbase) * 2), vb1 = *(const LAS u32x2*)(vb_ + ((32 + l31) * AT_VS + kbase + 8) * 2);
                    const bf16x8 vfa = __builtin_bit_cast(bf16x8, (u32x4){va0.x, va0.y, va1.x, va1.y});
                    const bf16x8 vfb = __builtin_bit_cast(bf16x8, (u32x4){vb0.x, vb0.y, vb1.x, vb1.y});
                    o0 = __builtin_amdgcn_mfma_f32_32x32x16_bf16(vfa, pf, o0, 0, 0, 0);
                    o1 = __builtin_amdgcn_mfma_f32_32x32x16_bf16(vfb, pf, o1, 0, 0, 0);
                }
            if (more) {
                LAS unsigned char* b = lds + ((j + 1) & 1) * AT_BUF;
                *(LAS u32x4*)(b + (kr0 * AT_KS + kc0 * 8) * 2) = gk0;
                if (tid < 256) *(LAS u32x4*)(b + (kr1 * AT_KS + kc1 * 8) * 2) = gk1;
                *(LAS u32x2*)(b + AT_KBYTES + (vd * AT_VS + vc * 8) * 2) = (u32x2){gv.x, gv.y};
                *(LAS u32x2*)(b + AT_KBYTES + (vd * AT_VS + vc * 8) * 2 + 8) = (u32x2){gv.z, gv.w};
            }
            __syncthreads();
        }
        __builtin_amdgcn_s_setprio(0);
        const float ltot = lsum + __shfl_xor(lsum, 32);
        const float inv = 1.0f / ltot;
        bf16_t* op = AO + (size_t)qrow * D + h * 64 + 4 * hl;
#pragma unroll
        for (int g = 0; g < 4; ++g) {
            u32x2 w; w.x = cvt_pk_bf16(o0[4 * g] * inv, o0[4 * g + 1] * inv); w.y = cvt_pk_bf16(o0[4 * g + 2] * inv, o0[4 * g + 3] * inv);
            *(u32x2*)(op + 8 * g) = w;
            u32x2 w2; w2.x = cvt_pk_bf16(o1[4 * g] * inv, o1[4 * g + 1] * inv); w2.y = cvt_pk_bf16(o1[4 * g + 2] * inv, o1[4 * g + 3] * inv);
            *(u32x2*)(op + 32 + 8 * g) = w2;
        }
    }
}

DI void pool_diff(const Ctx& p) {
    const int tid_ = otid(); const int NW = gridDim.x * 8, gw = blockIdx.x * 8 + (tid_ >> 6), lane = tid_ & 63;
    const float* Hf = (const float*)(p.ws() + OFF_Y); bf16_t* Dd = (bf16_t*)(p.ws() + OFF_H);
    for (int r = gw; r < M; r += NW) {
        const int base = r >= T ? T : 0, len = r >= T ? CL : T, t = r - base;
#pragma unroll
        for (int i = 0; i < 4; ++i) {
            const int half = 1 << i, c = i * 256 + lane * 4;
            int lo = t - half, hi = t + half; lo = lo < 0 ? 0 : lo; hi = hi > len ? len : hi;
            f32x4 sum = (f32x4){0.f, 0.f, 0.f, 0.f};
            for (int u = lo; u < hi; ++u) sum += *(const f32x4*)(Hf + (size_t)(base + u) * D + c);
            const f32x4 h = *(const f32x4*)(Hf + (size_t)r * D + c);
            const f32x4 df = sum * (1.0f / (float)(hi - lo)) - h;
            u32x2 w; w.x = cvt_pk_bf16(df[0], df[1]); w.y = cvt_pk_bf16(df[2], df[3]);
            *(u32x2*)(Dd + (size_t)r * D + c) = w;
        }
    }
}

__global__ void __launch_bounds__(NT) mega(Params kp) {
    extern __shared__ __attribute__((aligned(16))) unsigned char lds_raw[];
    LAS unsigned char* lds = (LAS unsigned char*)lds_raw;
    cg::grid_group grid = cg::this_grid();
    constexpr int LDS_MAIN_ = SC_LDS_BYTES > pg8::STAGE_BYTES ? SC_LDS_BYTES : pg8::STAGE_BYTES;
    { LAS unsigned* tw = (LAS unsigned*)(lds + LDS_MAIN_ + 64); if (threadIdx.x < 88) tw[threadIdx.x] = ((const unsigned*)&kp)[threadIdx.x]; }
    Ctx p; p.tab = (const LAS unsigned*)(lds + LDS_MAIN_ + 64);
    volatile LAS unsigned* bst = (volatile LAS unsigned*)(lds + (SC_LDS_BYTES > pg8::STAGE_BYTES ? SC_LDS_BYTES : pg8::STAGE_BYTES));
    if (threadIdx.x < 2) bst[threadIdx.x] = 0u;
    __syncthreads();
    const XcdBarrier xbar = xcd_barrier_post((unsigned*)(p.ws() + OFF_BAR), bst);
#define GSYNC() xcd_barrier(xbar)
    __syncthreads();
    unsigned char* ws = p.ws();
    bf16_t* H = (bf16_t*)(ws + OFF_H); float* Y = (float*)(ws + OFF_Y); bf16_t* ACT = (bf16_t*)(ws + OFF_X);

    { mod_phase(p, lds); int rot = 0; conv_mixers(p, rot); conv_ffn(p, 0, rot); }
    grid.sync();
    post_pre(p, 0, -1, 0.f, 0, 0, M, false, false, false);
    GSYNC();

    for (int i = 0; i < DEPTH; ++i) {
        const int kind = i % 3, j = i / 3;
        const bool last = i == DEPTH - 1;
        int used = 0;
        { pg8::EpiSwiglu E{ACT}; run_gemm(lds, H, D, (const bf16_t*)(ws + OFF_FFN), D, M, 2 * FF, D, E, used); }
        GSYNC();
        ffn_down(lds, p, ACT, (const bf16_t*)(ws + OFF_FFN + SZ_FFN1), Y, true, used);
        GSYNC();
        post_pre(p, i, 0, 0.5f, i, 1, M, kind != 1, false, true);
        GSYNC();
        if (kind == 0) {
            unsigned char* wb = ws + OFF_RWB + j * SZ_RWB;
            bf16_t* X = (bf16_t*)(ws + OFF_X);
            bf16_t* Rb = (bf16_t*)(ws + OFF_RKV); bf16_t* Kb = Rb + (size_t)M * D; bf16_t* Vb = j == 0 ? (bf16_t*)(ws + OFF_VF) : Kb + (size_t)M * D;
            bf16_t* L1a = H; bf16_t* L1b = H + (size_t)M * 256;
            rwkv_mix(p, j);
            GSYNC();
            {
                pg8::EpiB Er{Rb, D, 0, D, 0, nullptr, nullptr, 0}; run_gemm(lds, X + 0 * (size_t)M * D, D, (const bf16_t*)(wb + RWB_WR), D, M, D, D, Er, used);
                pg8::EpiB Ek{Kb, D, 0, D, 0, nullptr, nullptr, 0}; run_gemm(lds, X + 2 * (size_t)M * D, D, (const bf16_t*)(wb + RWB_WK), D, M, D, D, Ek, used);
                pg8::EpiB Ev{Vb, D, 0, D, 0, nullptr, nullptr, 0}; run_gemm(lds, X + 3 * (size_t)M * D, D, (const bf16_t*)(wb + RWB_WV), D, M, D, D, Ev, used);
                pg8::EpiB Ew{L1a, 256, 0, 128, 1, nullptr, nullptr, 0}; run_gemm(lds, X + 1 * (size_t)M * D, D, (const bf16_t*)(wb + RWB_W1W), D, M, 256, D, Ew, used);
                pg8::EpiB Ea{L1a, 256, 128, 128, 0, nullptr, nullptr, 0}; run_gemm(lds, X + 4 * (size_t)M * D, D, (const bf16_t*)(wb + RWB_W1A), D, M, 256, D, Ea, used);
                pg8::EpiB Eg{L1b, 256, 0, 160, 2, nullptr, nullptr, 0}; run_gemm(lds, X + 5 * (size_t)M * D, D, (const bf16_t*)(wb + RWB_W1G), D, M, 256, D, Eg, used);
                if (j == 1) { pg8::EpiB Ex{L1b, 256, 160, 96, 0, nullptr, nullptr, 0}; run_gemm(lds, X + 3 * (size_t)M * D, D, (const bf16_t*)(wb + RWB_W1V), D, M, 256, D, Ex, used); }
            }
            GSYNC();
            {
                pg8::EpiB E2a{X, D, 0, 4096, 3, p.in(16) + (size_t)j * 2 * D, p.in(19) + (size_t)j * 2 * D, (size_t)M * D};
                run_gemm(lds, L1a, 256, (const bf16_t*)(wb + RWB_W2A), 256, M, 4096, 256, E2a, used);
                pg8::EpiB E2b{X, D, 0, j == 1 ? 2048 : 1024, 4, nullptr, p.in(22), (size_t)M * D};
                run_gemm(lds, L1b, 256, (const bf16_t*)(wb + RWB_W2B), 256, M, j == 1 ? 2048 : 1024, 256, E2b, used);
            }
            GSYNC();
            ScanA A;
            A.R = Rb; A.K = Kb; A.V = Vb; A.VF = (const bf16_t*)(ws + OFF_VF); A.VG = X + 5 * (size_t)M * D;
            A.Mw0 = X; A.Mw1 = X + (size_t)M * D; A.Aa0 = X + 2 * (size_t)M * D; A.Aa1 = X + 3 * (size_t)M * D;
            A.kk_w = p.in(27) + (size_t)j * D; A.ka_w = p.in(28) + (size_t)j * D;
            A.y0 = Y; A.y1x = p.out(); A.y1c = (float*)(ws + OFF_Y1C); A.vres = j == 1; A.last = last;
            if (j == 1) scan_phase<true>(lds, A); else scan_phase<false>(lds, A);
            GSYNC();
            const int mrows = last ? T : M;
            rwkv_readout(p, j, mrows, A, X + 4 * (size_t)M * D, H);
            GSYNC();
            { pg8::EpiF32 E{Y, D}; run_gemm(lds, H, D, (const bf16_t*)(wb + RWB_WO), D, mrows, D, D, E, used); }
        } else if (kind == 1) {
            const bf16_t* wd = (const bf16_t*)(ws + OFF_MLA); const bf16_t* wuq = (const bf16_t*)(ws + OFF_MLA + SZ_WD);
            const bf16_t* wukv = (const bf16_t*)(ws + OFF_MLA + SZ_WD + SZ_WUQ); const bf16_t* wo = (const bf16_t*)(ws + OFF_MLA + SZ_WD + SZ_WUQ + SZ_WUKV);
            { pg8::EpiF32 E{Y, 768}; run_gemm(lds, H, D, wd, D, M, 768, D, E, used); }
            GSYNC();
            mla_norms(p);
            GSYNC();
            { pg8::EpiB Eq{(bf16_t*)(ws + OFF_Q), 1536, 0, 1536, 0, nullptr, nullptr, 0}; run_gemm(lds, (const bf16_t*)(ws + OFF_CQN), 384, wuq, 384, M, 1536, 384, Eq, used);
              pg8::EpiB Ekv{(bf16_t*)(ws + OFF_KV), 2048, 0, 2048, 0, nullptr, nullptr, 0}; run_gemm(lds, (const bf16_t*)(ws + OFF_CKVN), 256, wukv, 256, M, 2048, 256, Ekv, used); }
            GSYNC();
            mla_pack(p);
            GSYNC();
            attn_phase(lds, p);
            GSYNC();
            { pg8::EpiF32 E{Y, D}; run_gemm(lds, H, D, wo, D, M, D, D, E, used); }
        } else {
            pool_diff(p);
            GSYNC();
            { pg8::EpiPool E{Y, p.in(40) + (size_t)j * D, p.in(41) + (size_t)j * D}; run_gemm(lds, H, D, (const bf16_t*)(ws + OFF_POOLW), D, M, D, D, E, used); }
        }
        GSYNC();
        const int mrows = last ? T : M;
        post_pre(p, i, 1, 1.0f, i, 2, mrows, false, false, false);
        GSYNC();
        { pg8::EpiSwiglu E{ACT}; run_gemm(lds, H, D, (const bf16_t*)(ws + OFF_FFN + SZ_FFNS), D, mrows, 2 * FF, D, E, used); }
        GSYNC();
        ffn_down(lds, p, ACT, (const bf16_t*)(ws + OFF_FFN + SZ_FFNS + SZ_FFN1), Y, !last, used);
        GSYNC();
        if (!last) { post_pre(p, i, 2, 0.5f, i + 1, 0, M, false, false, true); int rot = 0; conv_ffn(p, i + 1, rot); }
        else post_pre(p, i, 2, 0.5f, 0, -1, T, false, true, false);
        if (!last) GSYNC();
    }
}

extern "C" void kernel_launch(void* const* d_in, const int* in_sizes, int n_in, void* d_out, int out_size, void* d_ws, size_t ws_size, hipStream_t stream) {
    static int grid_blocks = 0;
    constexpr int LDS_MAIN = SC_LDS_BYTES > pg8::STAGE_BYTES ? SC_LDS_BYTES : pg8::STAGE_BYTES;
    constexpr int LDS_BYTES = LDS_MAIN + 64 + 512;
    if (!grid_blocks) {
        if (n_in != 42 || ws_size < WS_TOTAL || out_size != T * D) { fprintf(stderr, "kernel_launch: unexpected problem (n_in %d ws %zu need %zu out %d)\n", n_in, ws_size, (size_t)WS_TOTAL, out_size); grid_blocks = -1; return; }
        int dev = 0, cus = 0, per_cu = 0;
        hipGetDevice(&dev);
        hipDeviceGetAttribute(&cus, hipDeviceAttributeMultiprocessorCount, dev);
        hipFuncSetAttribute((const void*)mega, hipFuncAttributeMaxDynamicSharedMemorySize, LDS_BYTES);
        hipOccupancyMaxActiveBlocksPerMultiprocessor(&per_cu, (const void*)mega, NT, LDS_BYTES);
        if (per_cu < 1) { fprintf(stderr, "kernel_launch: occupancy query says %d blocks per CU\n", per_cu); per_cu = 1; }
        grid_blocks = cus * per_cu;
        if (grid_blocks > 256) grid_blocks = 256;
    }
    if (grid_blocks < 0) return;
    if (hipMemsetAsync((unsigned char*)d_ws + OFF_BAR, 0, 16384, stream) != hipSuccess) { fprintf(stderr, "kernel_launch: memset failed\n"); return; }
    Params p{};
    for (int i = 0; i < 42; ++i) p.in[i] = (const float*)d_in[i];
    p.out = (float*)d_out; p.ws = (unsigned char*)d_ws;
    void* args[] = {&p};
    hipError_t e = hipLaunchCooperativeKernel((const void*)mega, dim3(grid_blocks), dim3(NT), args, LDS_BYTES, stream);
    if (e != hipSuccess) fprintf(stderr, "cooperative launch failed: %s (grid %d)\n", hipGetErrorString(e), grid_blocks);
}
```

```cpp
#include <hip/hip_runtime.h>
#include <hip/hip_cooperative_groups.h>
#include <cstdio>
namespace cg = cooperative_groups;

#define LAS __attribute__((address_space(3)))
#define DI __device__ __forceinline__
typedef unsigned short bf16_t;
typedef short bf16x8 __attribute__((ext_vector_type(8)));
typedef float f32x2 __attribute__((ext_vector_type(2)));
typedef float f32x4 __attribute__((ext_vector_type(4)));
typedef float f32x16 __attribute__((ext_vector_type(16)));
typedef unsigned u32x2 __attribute__((ext_vector_type(2)));
typedef unsigned u32x4 __attribute__((ext_vector_type(4)));

constexpr int D = 1024, FF = 2816, T = 16384, CL = 256, M = T + CL, DEPTH = 4;
constexpr int NT = 512;
constexpr float EPS = 1e-6f;
constexpr size_t MD2 = (size_t)M * D * 2;
constexpr size_t MD4 = (size_t)M * D * 4;

constexpr size_t SZ_MOD = (size_t)DEPTH * 2 * 9 * D * 4;
constexpr size_t SZ_SQ = (size_t)D * D * 2;
constexpr size_t SZ_W1 = (size_t)256 * D * 2;
constexpr size_t SZ_W2A = (size_t)4096 * 256 * 2, SZ_W2B = (size_t)2048 * 256 * 2;
constexpr size_t RWB_WR = 0, RWB_WK = SZ_SQ, RWB_WV = 2 * SZ_SQ, RWB_WO = 3 * SZ_SQ, RWB_W1W = 4 * SZ_SQ, RWB_W1A = RWB_W1W + SZ_W1, RWB_W1G = RWB_W1A + SZ_W1,
                 RWB_W1V = RWB_W1G + SZ_W1, RWB_W2A = RWB_W1V + SZ_W1, RWB_W2B = RWB_W2A + SZ_W2A, SZ_RWB = RWB_W2B + SZ_W2B;
constexpr size_t SZ_WD = (size_t)768 * D * 2, SZ_WUQ = (size_t)1536 * 384 * 2, SZ_WUKV = (size_t)2048 * 256 * 2;
constexpr size_t SZ_FFN1 = (size_t)2 * FF * D * 2, SZ_FFN2 = (size_t)D * FF * 2, SZ_FFNS = SZ_FFN1 + SZ_FFN2;
constexpr size_t OFF_MOD = 0;
constexpr size_t OFF_RWB = OFF_MOD + SZ_MOD;
constexpr size_t OFF_MLA = OFF_RWB + 2 * SZ_RWB;
constexpr size_t OFF_POOLW = OFF_MLA + SZ_WD + SZ_WUQ + SZ_WUKV + SZ_SQ;
constexpr size_t OFF_FFN = OFF_POOLW + SZ_SQ;
constexpr size_t OFF_S = OFF_FFN + 2 * SZ_FFNS;
constexpr size_t OFF_VF = OFF_S + MD4;
constexpr size_t OFF_Y = OFF_VF + MD2;
constexpr size_t OFF_H = OFF_Y + MD4;
constexpr size_t OFF_X = OFF_H + MD2;
constexpr size_t OFF_RKV = OFF_X + 6 * MD2;
constexpr size_t OFF_Y1C = OFF_RKV + 3 * MD2;
constexpr size_t OFF_BAR = OFF_Y1C + (size_t)CL * D * 4;
constexpr size_t WS_TOTAL = OFF_BAR + 16384;
constexpr size_t OFF_CQN = OFF_X, OFF_CKVN = OFF_CQN + (size_t)M * 384 * 2, OFF_KR = OFF_CKVN + (size_t)M * 256 * 2, OFF_Q = OFF_KR + (size_t)M * 32 * 4,
                 OFF_KV = OFF_Q + (size_t)M * 1536 * 2, OFF_KP = OFF_KV + (size_t)M * 2048 * 2, OFF_VT = OFF_KP + (size_t)M * 1536 * 2, OFF_MLA_END = OFF_VT + MD2;
static_assert(OFF_MLA_END <= OFF_Y1C, "mla scratch");
static_assert((size_t)M * FF * 2 <= 6 * MD2, "act scratch");
static_assert(OFF_X % 256 == 0 && OFF_FFN % 256 == 0 && OFF_S % 256 == 0, "align");

struct Params { const float* in[42]; float* out; unsigned char* ws; };
struct Ctx {
    const LAS unsigned* tab;
    DI unsigned long long q(int i) const { const unsigned lo = __builtin_amdgcn_readfirstlane(tab[2 * i]), hi = __builtin_amdgcn_readfirstlane(tab[2 * i + 1]); return ((unsigned long long)hi << 32) | lo; }
    DI const float* in(int i) const { return (const float*)(const __attribute__((address_space(1))) float*)q(i); }
    DI float* out() const { return (float*)(__attribute__((address_space(1))) float*)q(42); }
    DI unsigned char* ws() const { return (unsigned char*)(__attribute__((address_space(1))) unsigned char*)q(43); }
};

DI int otid() { int t = threadIdx.x; asm volatile("" : "+v"(t)); return t; }
DI float bf2f(bf16_t b) { return __uint_as_float((unsigned)b << 16); }
DI unsigned cvt_pk_bf16(float lo, float hi) { unsigned r; asm volatile("s_nop 1\n\tv_cvt_pk_bf16_f32 %0, %1, %2" : "=v"(r) : "v"(lo), "v"(hi)); return r; }
DI bf16_t f2bf(float f) { return (bf16_t)(cvt_pk_bf16(f, 0.f) & 0xffffu); }
DI float sigmoidf_(float x) { return __builtin_amdgcn_rcpf(1.0f + __builtin_amdgcn_exp2f(x * -1.4426950408889634f)); }
DI float tanhf_(float x) { return 1.0f - 2.0f * __builtin_amdgcn_rcpf(1.0f + __builtin_amdgcn_exp2f(x * 2.8853900817779268f)); }
DI float dpp_f(float x, const int ctrl_sel) {
    int xi = __builtin_bit_cast(int, x), r;
    if (ctrl_sel == 0) r = __builtin_amdgcn_update_dpp(0, xi, 0xB1, 0xF, 0xF, true);
    else if (ctrl_sel == 1) r = __builtin_amdgcn_update_dpp(0, xi, 0x4E, 0xF, 0xF, true);
    else if (ctrl_sel == 2) r = __builtin_amdgcn_update_dpp(0, xi, 0x141, 0xF, 0xF, true);
    else r = __builtin_amdgcn_update_dpp(0, xi, 0x140, 0xF, 0xF, true);
    return __builtin_bit_cast(float, r);
}
DI float red8(float v) { v += dpp_f(v, 0); v += dpp_f(v, 1); v += dpp_f(v, 2); return v; }
DI float red16(float v) { v += dpp_f(v, 0); v += dpp_f(v, 1); v += dpp_f(v, 2); v += dpp_f(v, 3); return v; }
DI float wave_sum(float v) {
    v = red16(v);
    { const unsigned x = __builtin_bit_cast(unsigned, v); auto pr = __builtin_amdgcn_permlane16_swap(x, x, false, false); v = __builtin_bit_cast(float, (unsigned)pr[0]) + __builtin_bit_cast(float, (unsigned)pr[1]); }
    { const unsigned x = __builtin_bit_cast(unsigned, v); auto pr = __builtin_amdgcn_permlane32_swap(x, x, false, false); v = __builtin_bit_cast(float, (unsigned)pr[0]) + __builtin_bit_cast(float, (unsigned)pr[1]); }
    return v;
}
DI void unpack8(const u32x4 w, float* f) {
    f[0] = __uint_as_float(w.x << 16); f[1] = __uint_as_float(w.x & 0xffff0000u); f[2] = __uint_as_float(w.y << 16); f[3] = __uint_as_float(w.y & 0xffff0000u);
    f[4] = __uint_as_float(w.z << 16); f[5] = __uint_as_float(w.z & 0xffff0000u); f[6] = __uint_as_float(w.w << 16); f[7] = __uint_as_float(w.w & 0xffff0000u);
}


#define XB_TMO      128
#define XB_XCNT(j)  (256  + 64 * (j))
#define XB_XSUB(j)  (1280 + 64 * (j))
#define XB_XGEN(j)  (2304 + 64 * (j))
#define XB_TOP      3328
#define XB_TOPGEN   3392
#define XCD_BAR_WORDS 3456
#define XB_SPIN_CAP (1u << 25)
DI unsigned xb_ld(unsigned* p)              { return __hip_atomic_load(p, __ATOMIC_RELAXED, __HIP_MEMORY_SCOPE_AGENT); }
DI unsigned xb_add(unsigned* p, unsigned v) { return __hip_atomic_fetch_add(p, v, __ATOMIC_RELAXED, __HIP_MEMORY_SCOPE_AGENT); }
DI unsigned xb_xcc_id() { return (unsigned)__builtin_amdgcn_s_getreg((3 << 11) | 20) & 0xFu; }
#define XB_SPIN(cond, bar) do { unsigned _sp = 0; while (cond) { __builtin_amdgcn_s_sleep(1); \
    if ((++_sp & 255u) == 0u) { if (xb_ld(&(bar)[XB_TMO])) break; if (_sp > XB_SPIN_CAP) { atomicAdd(&(bar)[XB_TMO], 1u); break; } } } } while (0)
struct XcdBarrier { unsigned* bar; unsigned x; volatile LAS unsigned* st; };
DI XcdBarrier xcd_barrier_post(unsigned* bar, volatile LAS unsigned* st) {
    XcdBarrier b; b.bar = bar; b.x = xb_xcc_id(); b.st = st;
    if (threadIdx.x == 0) (void)xb_add(&bar[XB_XCNT(b.x)], 1u);
    return b;
}
DI void xcd_barrier_complete(unsigned* bar, unsigned x, unsigned& nloc, unsigned& nx) {
    const unsigned G = gridDim.x * gridDim.y * gridDim.z;
    unsigned sum, cnt, mine, sp = 0u;
    for (;;) {
        sum = 0u; cnt = 0u; mine = 0u;
#pragma unroll
        for (unsigned j = 0; j < 16; ++j) { const unsigned c = xb_ld(&bar[XB_XCNT(j)]); sum += c; cnt += (c > 0u) ? 1u : 0u; mine = (j == x) ? c : mine; }
        if (sum == G) break;
        __builtin_amdgcn_s_sleep(1);
        if ((++sp & 255u) == 0u) { if (xb_ld(&bar[XB_TMO])) break; if (sp > XB_SPIN_CAP) { atomicAdd(&bar[XB_TMO], 1u); break; } }
    }
    nloc = mine > 0u ? mine : 1u; nx = cnt > 0u ? cnt : 1u;
}
DI void xcd_barrier(const XcdBarrier& b) {
    asm volatile("s_waitcnt vmcnt(0)" ::: "memory");
    __syncthreads();
    if (threadIdx.x == 0) {
        unsigned* bar = b.bar;
        __builtin_amdgcn_s_waitcnt(0);
        unsigned nloc = b.st[0], nx = b.st[1];
        if (nloc == 0u) { xcd_barrier_complete(bar, b.x, nloc, nx); b.st[0] = nloc; b.st[1] = nx; }
        const unsigned old = xb_add(&bar[XB_XSUB(b.x)], 1u);
        const unsigned gen = old / nloc;
        if (old + 1u == (gen + 1u) * nloc) {
            __builtin_amdgcn_fence(__ATOMIC_RELEASE, "agent");
            asm volatile("s_waitcnt vmcnt(0)" ::: "memory");
            const unsigned og = xb_add(&bar[XB_TOP], 1u);
            const unsigned tg = og / nx;
            if (og + 1u == (tg + 1u) * nx) xb_add(&bar[XB_TOPGEN], 1u);
            else XB_SPIN(xb_ld(&bar[XB_TOPGEN]) == tg, bar);
            __builtin_amdgcn_fence(__ATOMIC_ACQUIRE, "agent");
            xb_add(&bar[XB_XGEN(b.x)], 1u);
            asm volatile("s_waitcnt vmcnt(0)" ::: "memory");
        } else {
            XB_SPIN(xb_ld(&bar[XB_XGEN(b.x)]) == gen, bar);
            __builtin_amdgcn_fence(__ATOMIC_ACQUIRE, "agent");
            asm volatile("s_waitcnt vmcnt(0)" ::: "memory");
        }
    }
    __syncthreads();
}

namespace pg8 {
constexpr int BM = 256, BK = 64, HALF = 128, HTB = HALF * BK * 2, STAGE_BYTES = 8 * HTB, NXCD = 8, WGM = 8;
DI int lds_byte(int r, int c) { const int st = (r >> 4) * 2 + (c >> 5), rr = r & 15, cc = c & 31, ob = rr * 64 + cc * 2; return st * 1024 + (ob ^ (((ob >> 9) & 1) << 5)); }
DI void stage_rc(int b, int& R, int& C) { const int st = b / 1024, sb = b % 1024, swz = sb ^ (((sb >> 9) & 1) << 5); R = (st >> 1) * 16 + swz / 64; C = (st & 1) * 32 + (swz % 64) / 2; }
DI int perm32(int rho) { const int n = rho >> 4, i = rho & 15; return 8 * (i >> 2) + 4 * n + (i & 3); }
struct Unit { int pm, pn; };
struct Gemm { const bf16_t* A; const bf16_t* Bt; int M, N, K, lda, ldb; };
struct StaticOrder {
    int nM, nN, nwg, G, c;
    DI void init(int M_, int N_, int G_, int c_) { nM = M_ / BM; nN = N_ / BM; nwg = nM * nN; G = G_; c = c_; }
    DI bool next(int i, Unit& u) const {
        const long L = (long)i * G + c; if (L >= nwg) return false;
        int wgid = (int)L; { const int q = nwg / NXCD, r = nwg % NXCD, xcd = wgid % NXCD, off = wgid / NXCD; wgid = (xcd < r ? xcd * (q + 1) : r * (q + 1) + (xcd - r) * q) + off; }
        const int nig = WGM * nN, gid = wgid / nig, fm = gid * WGM, gsz = (nM - fm) < WGM ? (nM - fm) : WGM;
        u.pm = fm + ((wgid % nig) % gsz); u.pn = (wgid % nig) / gsz; return true;
    }
};
template <class Epi>
DI void gemm_phase(LAS unsigned char* lds, const Gemm g, const StaticOrder& S, const Epi& E) {
    const int tid = otid(), wid = __builtin_amdgcn_readfirstlane(tid >> 6), lane = tid & 63, wr = wid >> 2, wc = wid & 3, fr = lane & 15, fq = lane >> 4;
    const int K = g.K, nt = K / BK;
    unsigned voffA[2], voffB[2];
#pragma unroll
    for (int i = 0; i < 2; ++i) { int R, C; stage_rc(tid * 16 + i * 8192, R, C); const int Rb = (R & ~31) + perm32(R & 31);
        voffA[i] = (unsigned)(R * g.lda + C) * 2u; voffB[i] = (unsigned)(Rb * g.ldb + C) * 2u; }
    const size_t kstep = (size_t)(BK * 2);
    const size_t hA = (size_t)HALF * g.lda * 2, hB = (size_t)HALF * g.ldb * 2;
    const size_t tA = 2 * hA, tB = 2 * hB;
    const unsigned ldsw = (unsigned)wid * 1024u;
    const int aoff = lds_byte(wr * 64 + fr, fq * 8), boff = lds_byte(wc * 32 + fr, fq * 8);
#define PG8_SA(b, h) (((b) * 2 + (h)) * HTB)
#define PG8_SB(b, h) ((4 + (b) * 2 + (h)) * HTB)
#define PG8_STAGE(bufoff, gbase, voff) do { _Pragma("unroll") for (int _i = 0; _i < 2; ++_i) \
        __builtin_amdgcn_global_load_lds((const unsigned*)((const char*)(gbase) + (voff)[_i]), (LAS unsigned*)(lds + (bufoff) + ldsw + _i * 8192), 16, 0, 0); } while (0)
#define PG8_LDA(dst, b, h) do { _Pragma("unroll") for (int m = 0; m < 4; ++m) _Pragma("unroll") for (int k = 0; k < 2; ++k) dst[m][k] = *(const LAS bf16x8*)(lds + PG8_SA(b, h) + aoff + m * 2048 + k * 1024); } while (0)
#define PG8_LDB(dst, b, h) do { _Pragma("unroll") for (int n = 0; n < 2; ++n) _Pragma("unroll") for (int k = 0; k < 2; ++k) dst[n][k] = *(const LAS bf16x8*)(lds + PG8_SB(b, h) + boff + n * 2048 + k * 1024); } while (0)
#define PG8_MMA(ai, bj, At, Bt) do { __builtin_amdgcn_s_setprio(1); _Pragma("unroll") for (int m = 0; m < 4; ++m) _Pragma("unroll") for (int n = 0; n < 2; ++n) _Pragma("unroll") for (int k = 0; k < 2; ++k) \
        acc[ai][bj][m][n] = __builtin_amdgcn_mfma_f32_16x16x32_bf16(Bt[n][k], At[m][k], acc[ai][bj][m][n], 0, 0, 0); __builtin_amdgcn_s_setprio(0); } while (0)
#define PG8_WAIT_V(n) asm volatile("s_waitcnt vmcnt(" #n ")" ::: "memory")
#define PG8_WAIT_L(n) asm volatile("s_waitcnt lgkmcnt(" #n ")" ::: "memory")
#define PG8_BAR __builtin_amdgcn_s_barrier()
#define PG8_SCHED __builtin_amdgcn_sched_barrier(0)
    Unit cur, nxt; int ui = 0;
    if (!S.next(0, cur)) return;
    f32x4 acc[2][2][4][2];
#pragma unroll
    for (int a = 0; a < 2; ++a)
#pragma unroll
        for (int b = 0; b < 2; ++b)
#pragma unroll
            for (int m = 0; m < 4; ++m)
#pragma unroll
                for (int n = 0; n < 2; ++n) acc[a][b][m][n] = (f32x4){0.f, 0.f, 0.f, 0.f};
    bf16x8 At[4][2], B0[2][2], B1[2][2];
    const char* cA = (const char*)g.A + (size_t)cur.pm * tA; const char* cB = (const char*)g.Bt + (size_t)cur.pn * tB;
    PG8_STAGE(PG8_SB(0, 0), cB, voffB); PG8_STAGE(PG8_SA(0, 0), cA, voffA); PG8_STAGE(PG8_SB(0, 1), cB + hB, voffB); PG8_STAGE(PG8_SA(0, 1), cA + hA, voffA);
    if (wr == 1) PG8_BAR;
    PG8_WAIT_V(4); PG8_BAR;
    PG8_STAGE(PG8_SB(1, 0), cB + kstep, voffB); PG8_STAGE(PG8_SA(1, 0), cA + kstep, voffA); PG8_STAGE(PG8_SB(1, 1), cB + hB + kstep, voffB);
    PG8_WAIT_V(6); PG8_BAR;
    for (;;) {
        const bool has_next = S.next(ui + 1, nxt);
        const char* nA = has_next ? (const char*)g.A + (size_t)nxt.pm * tA : cA; const char* nB = has_next ? (const char*)g.Bt + (size_t)nxt.pn * tB : cB;
        for (int t = 0; t < nt; t += 2) {
            const bool last = (t == nt - 2);
            const char* a1 = cA + (size_t)(t + 1) * kstep;
            const char* a2 = last ? nA : cA + (size_t)(t + 2) * kstep; const char* b2 = last ? nB : cB + (size_t)(t + 2) * kstep;
            const char* a3 = a2 + kstep; const char* b3 = b2 + kstep;
            PG8_LDB(B0, 0, 0); PG8_SCHED; PG8_LDA(At, 0, 0); PG8_STAGE(PG8_SA(1, 1), a1 + hA, voffA);
            PG8_WAIT_L(8); PG8_BAR; PG8_WAIT_L(0); PG8_MMA(0, 0, At, B0); PG8_BAR; PG8_SCHED;
            PG8_LDB(B1, 0, 1); PG8_STAGE(PG8_SB(0, 0), b2, voffB);
            PG8_BAR; PG8_WAIT_L(0); PG8_MMA(0, 1, At, B1); PG8_BAR;
            PG8_LDA(At, 0, 1); PG8_STAGE(PG8_SA(0, 0), a2, voffA);
            PG8_BAR; PG8_WAIT_L(0); PG8_MMA(1, 0, At, B0); PG8_BAR; PG8_SCHED;
            PG8_STAGE(PG8_SB(0, 1), b2 + hB, voffB);
            PG8_WAIT_V(6); PG8_BAR; PG8_MMA(1, 1, At, B1); PG8_BAR;
            PG8_LDB(B0, 1, 0); PG8_SCHED; PG8_LDA(At, 1, 0); PG8_STAGE(PG8_SA(0, 1), a2 + hA, voffA);
            PG8_WAIT_L(8); PG8_BAR; PG8_WAIT_L(0); PG8_MMA(0, 0, At, B0); PG8_BAR; PG8_SCHED;
            PG8_LDB(B1, 1, 1); PG8_STAGE(PG8_SB(1, 0), b3, voffB);
            PG8_BAR; PG8_WAIT_L(0); PG8_MMA(0, 1, At, B1); PG8_BAR;
            PG8_LDA(At, 1, 1); PG8_STAGE(PG8_SA(1, 0), a3, voffA);
            PG8_BAR; PG8_WAIT_L(0); PG8_MMA(1, 0, At, B0); PG8_BAR; PG8_SCHED;
            PG8_STAGE(PG8_SB(1, 1), b3 + hB, voffB);
            PG8_WAIT_V(6); PG8_BAR; PG8_MMA(1, 1, At, B1); PG8_BAR;
        }
        E(acc, cur, wr, wc, fr, fq);
        if (!has_next) break;
#pragma unroll
        for (int a = 0; a < 2; ++a)
#pragma unroll
            for (int b = 0; b < 2; ++b)
#pragma unroll
                for (int m = 0; m < 4; ++m)
#pragma unroll
                    for (int n = 0; n < 2; ++n) acc[a][b][m][n] = (f32x4){0.f, 0.f, 0.f, 0.f};
        cur = nxt; cA = nA; cB = nB; ++ui;
    }
    PG8_WAIT_V(0);
    if (wr == 0) PG8_BAR;
    PG8_BAR;
#undef PG8_SA
#undef PG8_SB
#undef PG8_STAGE
#undef PG8_LDA
#undef PG8_LDB
#undef PG8_MMA
#undef PG8_WAIT_V
#undef PG8_WAIT_L
#undef PG8_BAR
#undef PG8_SCHED
}

struct EpiF32 {
    float* C; int ldc;
    DI void operator()(const f32x4 (&acc)[2][2][4][2], const Unit& u, int wr, int wc, int fr, int fq) const {
        const int row0 = u.pm * BM + wr * 64 + fr, col0 = u.pn * BM + wc * 32 + 8 * fq;
#pragma unroll
        for (int ai = 0; ai < 2; ++ai)
#pragma unroll
            for (int m = 0; m < 4; ++m) { float* rowp = C + (size_t)(row0 + ai * HALF + m * 16) * ldc + col0;
#pragma unroll
                for (int bj = 0; bj < 2; ++bj) { *(f32x4*)(rowp + bj * HALF) = acc[ai][bj][m][0]; *(f32x4*)(rowp + bj * HALF + 4) = acc[ai][bj][m][1]; } }
    }
};
struct EpiPool {
    float* C; const float* bias; const float* scale;
    DI void operator()(const f32x4 (&acc)[2][2][4][2], const Unit& u, int wr, int wc, int fr, int fq) const {
        const int row0 = u.pm * BM + wr * 64 + fr, col0 = u.pn * BM + wc * 32 + 8 * fq;
#pragma unroll
        for (int bj = 0; bj < 2; ++bj) {
            const f32x4 b0 = *(const f32x4*)(bias + col0 + bj * HALF), b1 = *(const f32x4*)(bias + col0 + bj * HALF + 4);
            const f32x4 s0 = *(const f32x4*)(scale + col0 + bj * HALF), s1 = *(const f32x4*)(scale + col0 + bj * HALF + 4);
#pragma unroll
            for (int ai = 0; ai < 2; ++ai)
#pragma unroll
                for (int m = 0; m < 4; ++m) { float* rowp = C + (size_t)(row0 + ai * HALF + m * 16) * D + col0 + bj * HALF;
                    *(f32x4*)(rowp) = (acc[ai][bj][m][0] + b0) * s0; *(f32x4*)(rowp + 4) = (acc[ai][bj][m][1] + b1) * s1; } }
    }
};
struct EpiSwiglu {
    bf16_t* O;
    DI void operator()(const f32x4 (&acc)[2][2][4][2], const Unit& u, int wr, int wc, int fr, int fq) const {
        const int row0 = u.pm * BM + wr * 64 + fr, col0 = u.pn * HALF + wc * 32 + 8 * fq;
#pragma unroll
        for (int ai = 0; ai < 2; ++ai)
#pragma unroll
            for (int m = 0; m < 4; ++m) {
                float o[8];
#pragma unroll
                for (int n = 0; n < 2; ++n)
#pragma unroll
                    for (int j = 0; j < 4; ++j) { const float gv = acc[ai][0][m][n][j], uv = acc[ai][1][m][n][j]; o[n * 4 + j] = gv * sigmoidf_(gv) * uv; }
                u32x4 w; w.x = cvt_pk_bf16(o[0], o[1]); w.y = cvt_pk_bf16(o[2], o[3]); w.z = cvt_pk_bf16(o[4], o[5]); w.w = cvt_pk_bf16(o[6], o[7]);
                *(u32x4*)(O + (size_t)(row0 + ai * HALF + m * 16) * FF + col0) = w; }
    }
};
struct EpiB {
    bf16_t* O; int ldc, coloff, ncols, mode; const float* b0; const float* b1; size_t sstride;
    DI void operator()(const f32x4 (&acc)[2][2][4][2], const Unit& u, int wr, int wc, int fr, int fq) const {
        const int row0 = u.pm * BM + wr * 64 + fr;
#pragma unroll
        for (int bj = 0; bj < 2; ++bj) {
            const int c = u.pn * BM + bj * HALF + wc * 32 + 8 * fq;
            if (c >= ncols) continue;
            int act = mode; const float* bias = nullptr; bf16_t* dst = O + coloff + c;
            if (mode == 3) { const int buf = c >> 10, cc = c & 1023; act = buf < 2 ? 3 : 2; bias = buf < 2 ? b0 + c : b1 + (c - 2048); dst = O + (size_t)buf * sstride + cc; }
            else if (mode == 4) { const int buf = c >> 10, cc = c & 1023; act = buf ? 2 : 0; bias = buf ? b1 + cc : nullptr; dst = O + (size_t)(4 + buf) * sstride + cc; }
            f32x4 bv0 = (f32x4){0.f, 0.f, 0.f, 0.f}, bv1 = bv0;
            if (bias) { bv0 = *(const f32x4*)bias; bv1 = *(const f32x4*)(bias + 4); }
#pragma unroll
            for (int ai = 0; ai < 2; ++ai)
#pragma unroll
                for (int m = 0; m < 4; ++m) {
                    f32x4 v0 = acc[ai][bj][m][0] + bv0, v1 = acc[ai][bj][m][1] + bv1;
                    float o[8] = {v0[0], v0[1], v0[2], v0[3], v1[0], v1[1], v1[2], v1[3]};
                    if (act == 1) {
#pragma unroll
                        for (int j = 0; j < 8; ++j) o[j] = tanhf_(o[j]);
                    } else if (act == 2) {
#pragma unroll
                        for (int j = 0; j < 8; ++j) o[j] = sigmoidf_(o[j]);
                    } else if (act == 3) {
#pragma unroll
                        for (int j = 0; j < 8; ++j) o[j] = 0.60653066f * sigmoidf_(o[j]);
                    }
                    u32x4 w; w.x = cvt_pk_bf16(o[0], o[1]); w.y = cvt_pk_bf16(o[2], o[3]); w.z = cvt_pk_bf16(o[4], o[5]); w.w = cvt_pk_bf16(o[6], o[7]);
                    *(u32x4*)(dst + (size_t)(row0 + ai * HALF + m * 16) * ldc) = w; }
        }
    }
};
}

template <class Epi>
DI void run_gemm(LAS unsigned char* lds, const bf16_t* A, int lda, const bf16_t* Bt, int ldb, int Mr, int N, int K, const Epi& E, int& used) {
    const int G = gridDim.x;
    pg8::Gemm g{A, Bt, Mr, N, K, lda, ldb};
    pg8::StaticOrder S; S.init(Mr, N, G, (int)((blockIdx.x + G - (used % G)) % G));
    pg8::gemm_phase<Epi>(lds, g, S, E);
    used += S.nwg;
}


DI void ffn_down(LAS unsigned char* lds, const Ctx& p, const bf16_t* ACT, const bf16_t* W2, float* Y, bool with_ctx, int& used) {
    { pg8::EpiF32 E{Y, D}; run_gemm(lds, ACT, FF, W2, FF, T, D, FF, E, used); }
    if (with_ctx) {
        float* part = (float*)(p.ws() + OFF_RKV);
        for (int kc = 0; kc < 11; ++kc) { pg8::EpiF32 E{part + (size_t)kc * CL * D, D}; run_gemm(lds, ACT + (size_t)T * FF + kc * 256, FF, W2 + kc * 256, FF, CL, D, 256, E, used); }
    }
}

DI void conv_t(const float* __restrict__ src, int sld, bf16_t* __restrict__ dst, int dld, int N, int K, int& rot) {
    const int tid_ = otid(); const int NW = gridDim.x * 8, gw = blockIdx.x * 8 + (tid_ >> 6), lane = tid_ & 63;
    const int ntn = N >> 4, ntile = ntn * (K >> 5);
    for (int t = (gw + NW - (rot % NW)) % NW; t < ntile; t += NW) {
        const int tn = t % ntn, tk = t / ntn;
        const int n = tn * 16 + (lane & 15), k0 = tk * 32 + (lane >> 4) * 8;
        const float* s = src + (size_t)k0 * sld + n;
        float v[8];
#pragma unroll
        for (int j = 0; j < 8; ++j) v[j] = __builtin_nontemporal_load(s + (size_t)j * sld);
        u32x4 w; w.x = cvt_pk_bf16(v[0], v[1]); w.y = cvt_pk_bf16(v[2], v[3]); w.z = cvt_pk_bf16(v[4], v[5]); w.w = cvt_pk_bf16(v[6], v[7]);
        *(u32x4*)(dst + (size_t)n * dld + k0) = w;
    }
    rot += ntile;
}
DI void zblock(bf16_t* dst, int dld, int N, int K) {
    const int kc = K >> 3, tot = N * kc;
    for (int q = blockIdx.x * NT + otid(); q < tot; q += gridDim.x * NT) { const int n = q / kc, c = q % kc; *(u32x4*)(dst + (size_t)n * dld + c * 8) = (u32x4){0u, 0u, 0u, 0u}; }
}
DI void conv_ffn(const Ctx& p, int layer, int& rot) {
    for (int s = 0; s < 2; ++s) {
        const float* wg = p.in(8) + (size_t)(layer * 2 + s) * D * FF;
        const float* wu = p.in(9) + (size_t)(layer * 2 + s) * D * FF;
        const float* wd = p.in(10) + (size_t)(layer * 2 + s) * FF * D;
        bf16_t* w1 = (bf16_t*)(p.ws() + OFF_FFN + s * SZ_FFNS);
        bf16_t* w2 = (bf16_t*)(p.ws() + OFF_FFN + s * SZ_FFNS + SZ_FFN1);
        for (int pn = 0; pn < 22; ++pn) {
            conv_t(wg + pn * 128, FF, w1 + (size_t)(pn * 256) * D, D, 128, D, rot);
            conv_t(wu + pn * 128, FF, w1 + (size_t)(pn * 256 + 128) * D, D, 128, D, rot);
        }
        conv_t(wd, D, w2, FF, D, FF, rot);
    }
}
DI void conv_mixers(const Ctx& p, int& rot) {
    for (int j = 0; j < 2; ++j) {
        unsigned char* b = p.ws() + OFF_RWB + j * SZ_RWB;
        conv_t(p.in(12) + (size_t)j * D * D, D, (bf16_t*)(b + RWB_WR), D, D, D, rot);
        conv_t(p.in(13) + (size_t)j * D * D, D, (bf16_t*)(b + RWB_WK), D, D, D, rot);
        conv_t(p.in(14) + (size_t)j * D * D, D, (bf16_t*)(b + RWB_WV), D, D, D, rot);
        conv_t(p.in(15) + (size_t)j * D * D, D, (bf16_t*)(b + RWB_WO), D, D, D, rot);
        bf16_t* w1w = (bf16_t*)(b + RWB_W1W); bf16_t* w1a = (bf16_t*)(b + RWB_W1A); bf16_t* w1g = (bf16_t*)(b + RWB_W1G); bf16_t* w1v = (bf16_t*)(b + RWB_W1V);
        for (int d = 0; d < 2; ++d) {
            conv_t(p.in(17) + (size_t)(j * 2 + d) * D * 64, 64, w1w + (size_t)d * 64 * D, D, 64, D, rot);
            conv_t(p.in(20) + (size_t)(j * 2 + d) * D * 64, 64, w1a + (size_t)d * 64 * D, D, 64, D, rot);
        }
        zblock(w1w + (size_t)128 * D, D, 128, D); zblock(w1a + (size_t)128 * D, D, 128, D);
        conv_t(p.in(25) + (size_t)j * D * 160, 160, w1g, D, 160, D, rot);
        zblock(w1g + (size_t)160 * D, D, 96, D);
        if (j == 1) { conv_t(p.in(23), 32, w1v, D, 32, D, rot); zblock(w1v + (size_t)32 * D, D, 224, D); }
        bf16_t* w2a = (bf16_t*)(b + RWB_W2A); bf16_t* w2b = (bf16_t*)(b + RWB_W2B);
        for (int q = 0; q < 4; ++q) {
            const float* src = (q < 2 ? p.in(18) : p.in(21)) + (size_t)(j * 2 + (q & 1)) * 64 * D;
            conv_t(src, D, w2a + (size_t)(q * 1024) * 256 + q * 64, 256, D, 64, rot);
            for (int z = 0; z < 4; ++z) if (z != q) zblock(w2a + (size_t)(q * 1024) * 256 + z * 64, 256, D, 64);
        }
        conv_t(p.in(26) + (size_t)j * 160 * D, D, w2b, 256, D, 160, rot);
        zblock(w2b + 160, 256, D, 96);
        if (j == 1) { conv_t(p.in(24), D, w2b + (size_t)1024 * 256 + 160, 256, D, 32, rot); zblock(w2b + (size_t)1024 * 256, 256, D, 160); zblock(w2b + (size_t)1024 * 256 + 192, 256, D, 64); }
    }
    {
        bf16_t* wd = (bf16_t*)(p.ws() + OFF_MLA); bf16_t* wuq = (bf16_t*)(p.ws() + OFF_MLA + SZ_WD); bf16_t* wukv = (bf16_t*)(p.ws() + OFF_MLA + SZ_WD + SZ_WUQ); bf16_t* wo = (bf16_t*)(p.ws() + OFF_MLA + SZ_WD + SZ_WUQ + SZ_WUKV);
        conv_t(p.in(32), 384, wd, D, 384, D, rot);
        conv_t(p.in(35), 288, wd + (size_t)384 * D, D, 288, D, rot);
        zblock(wd + (size_t)672 * D, D, 96, D);
        conv_t(p.in(34), 1536, wuq, 384, 1536, 384, rot);
        conv_t(p.in(37), 2048, wukv, 256, 2048, 256, rot);
        conv_t(p.in(38), D, wo, D, D, D, rot);
    }
    {
        bf16_t* wp = (bf16_t*)(p.ws() + OFF_POOLW);
        for (int g = 0; g < 4; ++g) for (int h = 0; h < 4; ++h) {
            if (g == h) conv_t(p.in(39) + (size_t)g * 256 * 256, 256, wp + (size_t)(g * 256) * D + g * 256, D, 256, 256, rot);
            else zblock(wp + (size_t)(g * 256) * D + h * 256, D, 256, 256);
        }
    }
}

DI void mod_phase(const Ctx& p, LAS unsigned char* lds) {
    LAS float* red = (LAS float*)lds;
    const int tid = otid(), wid = tid >> 6, lane = tid & 63;
    float* MOD = (float*)(p.ws() + OFF_MOD);
    for (int item = blockIdx.x; item < DEPTH * 36; item += gridDim.x) {
        const int layer = item / 36, cg_ = item % 36;
        const float* W = p.in(4) + (size_t)layer * D * 9 * D + cg_ * 256 + lane * 4;
        f32x4 a0 = (f32x4){0.f, 0.f, 0.f, 0.f}, a1 = a0;
        for (int k = wid * 128; k < wid * 128 + 128; ++k) {
            const float c0 = p.in(1)[k], c1 = p.in(3)[k];
            const float s0 = c0 * sigmoidf_(c0), s1 = c1 * sigmoidf_(c1);
            const f32x4 w = __builtin_nontemporal_load((const f32x4*)(W + (size_t)k * 9 * D));
            a0 += w * s0; a1 += w * s1;
        }
        *(LAS f32x4*)(red + (wid * 2 + 0) * 256 + lane * 4) = a0;
        *(LAS f32x4*)(red + (wid * 2 + 1) * 256 + lane * 4) = a1;
        __syncthreads();
        { const int s = tid >> 8, cc = tid & 255; float v = p.in(5)[layer * 9 * D + cg_ * 256 + cc];
#pragma unroll
          for (int w = 0; w < 8; ++w) v += red[(w * 2 + s) * 256 + cc];
          MOD[(size_t)(layer * 2 + s) * 9 * D + cg_ * 256 + cc] = v; }
        __syncthreads();
    }
}

DI void pp_load(const Ctx& p, int slotp, bool ypart, bool from_in, int r, int lane, f32x4 (&s)[4], f32x4 (&y)[4]) {
    const int st = r >= T ? 1 : 0;
    const float* sp = from_in ? (st ? p.in(2) + (size_t)(r - T) * D : p.in(0) + (size_t)r * D) : (const float*)(p.ws() + OFF_S) + (size_t)r * D;
#pragma unroll
    for (int i = 0; i < 4; ++i) s[i] = __builtin_nontemporal_load((const f32x4*)(sp + i * 256 + lane * 4));
    if (slotp < 0) {
#pragma unroll
        for (int i = 0; i < 4; ++i) y[i] = s[i];
    } else {
        const float* Y = (const float*)(p.ws() + OFF_Y);
#pragma unroll
        for (int i = 0; i < 4; ++i) {
            if (ypart && st) { const float* pp = (const float*)(p.ws() + OFF_RKV) + (size_t)(r - T) * D + i * 256 + lane * 4; f32x4 a = *(const f32x4*)pp;
#pragma unroll
                for (int kc = 1; kc < 11; ++kc) a += *(const f32x4*)(pp + (size_t)kc * CL * D);
                y[i] = a; }
            else y[i] = *(const f32x4*)(Y + (size_t)r * D + i * 256 + lane * 4); }
    }
}
DI void pp_proc(const Ctx& p, int lp, int slotp, float wgt, int lq, int slotq, bool hf32, bool fin, int r, int lane, f32x4 (&s)[4], const f32x4 (&y)[4]) {
    const int st = r >= T ? 1 : 0;
    float* S = (float*)(p.ws() + OFF_S); float* Y = (float*)(p.ws() + OFF_Y); bf16_t* H = (bf16_t*)(p.ws() + OFF_H);
    const float* MOD = (const float*)(p.ws() + OFF_MOD);
    if (slotp >= 0) {
        float ss = 0.f;
#pragma unroll
        for (int i = 0; i < 4; ++i) ss += y[i][0] * y[i][0] + y[i][1] * y[i][1] + y[i][2] * y[i][2] + y[i][3] * y[i][3];
        ss = wave_sum(ss);
        const float rs = rsqrtf(ss * (1.0f / D) + EPS) * wgt;
        const float* gate = MOD + (size_t)((lp * 2 + st) * 9 + 3 * slotp + 2) * D;
        const float* gp = p.in(7) + (size_t)(lp * 3 + slotp) * D;
#pragma unroll
        for (int i = 0; i < 4; ++i) { const f32x4 gt = *(const f32x4*)(gate + i * 256 + lane * 4), gg = *(const f32x4*)(gp + i * 256 + lane * 4); s[i] += gt * (y[i] * rs * gg); }
    }
    if (fin) {
#pragma unroll
        for (int i = 0; i < 4; ++i) *(f32x4*)(p.out() + (size_t)r * D + i * 256 + lane * 4) = s[i];
    } else if (slotp >= 0) {
#pragma unroll
        for (int i = 0; i < 4; ++i) __builtin_nontemporal_store(s[i], (f32x4*)(S + (size_t)r * D + i * 256 + lane * 4));
    }
    if (slotq >= 0) {
        float ss = 0.f;
#pragma unroll
        for (int i = 0; i < 4; ++i) ss += s[i][0] * s[i][0] + s[i][1] * s[i][1] + s[i][2] * s[i][2] + s[i][3] * s[i][3];
        ss = wave_sum(ss);
        const float rs = rsqrtf(ss * (1.0f / D) + EPS);
        const float* shift = MOD + (size_t)((lq * 2 + st) * 9 + 3 * slotq) * D;
        const float* scale = shift + D;
        const float* gq = p.in(6) + (size_t)(lq * 3 + slotq) * D;
#pragma unroll
        for (int i = 0; i < 4; ++i) {
            const f32x4 sh = *(const f32x4*)(shift + i * 256 + lane * 4), sc = *(const f32x4*)(scale + i * 256 + lane * 4), gg = *(const f32x4*)(gq + i * 256 + lane * 4);
            const f32x4 h = s[i] * rs * gg * (sc + 1.0f) + sh;
            if (hf32) *(f32x4*)(Y + (size_t)r * D + i * 256 + lane * 4) = h;
            else { u32x2 w; w.x = cvt_pk_bf16(h[0], h[1]); w.y = cvt_pk_bf16(h[2], h[3]); *(u32x2*)(H + (size_t)r * D + i * 256 + lane * 4) = w; }
        }
    }
}
DI void post_pre(const Ctx& p, int lp, int slotp, float wgt, int lq, int slotq, int nrows, bool hf32, bool fin, bool ypart) {
    const int tid_ = otid(); const int NW = gridDim.x * 8, gw = blockIdx.x * 8 + (tid_ >> 6), lane = tid_ & 63;
    const bool from_in = slotp < 0 || (lp == 0 && slotp == 0);
    for (int r = gw; r < nrows; r += 4 * NW) {
        const int r1 = r + NW, r2 = r + 2 * NW, r3 = r + 3 * NW;
        f32x4 s0[4], y0[4], s1[4], y1[4], s2[4], y2[4], s3[4], y3[4];
        pp_load(p, slotp, ypart, from_in, r, lane, s0, y0);
        if (r1 < nrows) pp_load(p, slotp, ypart, from_in, r1, lane, s1, y1);
        if (r2 < nrows) pp_load(p, slotp, ypart, from_in, r2, lane, s2, y2);
        if (r3 < nrows) pp_load(p, slotp, ypart, from_in, r3, lane, s3, y3);
        pp_proc(p, lp, slotp, wgt, lq, slotq, hf32, fin, r, lane, s0, y0);
        if (r1 < nrows) pp_proc(p, lp, slotp, wgt, lq, slotq, hf32, fin, r1, lane, s1, y1);
        if (r2 < nrows) pp_proc(p, lp, slotp, wgt, lq, slotq, hf32, fin, r2, lane, s2, y2);
        if (r3 < nrows) pp_proc(p, lp, slotp, wgt, lq, slotq, hf32, fin, r3, lane, s3, y3);
    }
}

DI void rwkv_mix(const Ctx& p, int j) {
    const int tid_ = otid(); const int NW = gridDim.x * 8, gw = blockIdx.x * 8 + (tid_ >> 6), lane = tid_ & 63;
    const float* Hf = (const float*)(p.ws() + OFF_Y);
    bf16_t* X = (bf16_t*)(p.ws() + OFF_X);
    bf16_t* L1b = (bf16_t*)(p.ws() + OFF_H) + (size_t)M * 256;
    const float* mu = p.in(11) + (size_t)j * 6 * D;
    for (int r = gw; r < M; r += NW) {
        const bool first = (r == 0) || (r == T), last = (r == T - 1) || (r == M - 1);
#pragma unroll
        for (int i = 0; i < 4; ++i) {
            const int c = i * 256 + lane * 4;
            const f32x4 h = *(const f32x4*)(Hf + (size_t)r * D + c);
            const f32x4 pv = first ? (f32x4){0.f, 0.f, 0.f, 0.f} : *(const f32x4*)(Hf + (size_t)(r - 1) * D + c);
            const f32x4 nx = last ? (f32x4){0.f, 0.f, 0.f, 0.f} : *(const f32x4*)(Hf + (size_t)(r + 1) * D + c);
            const f32x4 xx = (pv + nx) * 0.5f - h;
#pragma unroll
            for (int n = 0; n < 6; ++n) {
                const f32x4 m = *(const f32x4*)(mu + n * D + c);
                const f32x4 v = h + xx * m;
                u32x2 w; w.x = cvt_pk_bf16(v[0], v[1]); w.y = cvt_pk_bf16(v[2], v[3]);
                *(u32x2*)(X + (size_t)n * M * D + (size_t)r * D + c) = w;
            }
        }
        if (lane < 12) { unsigned z = 0u; asm volatile("" : "+v"(z)); *(u32x4*)(L1b + (size_t)r * 256 + 160 + lane * 8) = (u32x4){z, z, z, z}; }
    }
}

struct ScanA { const bf16_t* R; const bf16_t* K; const bf16_t* V; const bf16_t* VF; const bf16_t* VG; const bf16_t* Mw0; const bf16_t* Mw1; const bf16_t* Aa0; const bf16_t* Aa1;
               const float* kk_w; const float* ka_w; float* y0; float* y1x; float* y1c; int vres; int last; };
constexpr int SC_CH = 32, SC_STEP = 5 * 64 + 16, SC_BUF = SC_CH * SC_STEP, SC_YBUF = SC_CH * 128;
constexpr int SC_LDS_BYTES = (2 * SC_BUF + 2 * SC_YBUF) * 4;
DI int scan_row(int dir, int s) { return dir == 0 ? (s < CL ? T + s : s - CL) : (s < CL ? M - 1 - s : T - 1 - (s - CL)); }
struct ScanRaw { u32x4 k, a, m, r, v, vf, vg; };
template <bool VRES> DI void scan_load(const ScanA& A, int dir, int head, int chunk, int pt, ScanRaw& w) {
    const int row = scan_row(dir, chunk * SC_CH + (pt >> 3));
    const size_t off = (size_t)row * D + head * 64 + (pt & 7) * 8;
    w.k = *(const u32x4*)(A.K + off); w.a = *(const u32x4*)((dir ? A.Aa1 : A.Aa0) + off); w.m = *(const u32x4*)((dir ? A.Mw1 : A.Mw0) + off); w.r = *(const u32x4*)(A.R + off); w.v = *(const u32x4*)(A.V + off);
    if (VRES) { w.vf = *(const u32x4*)(A.VF + off); w.vg = *(const u32x4*)(A.VG + off); }
}
template <bool VRES> DI void scan_prep(const ScanA& A, const ScanRaw& w, const float* kkw, const float* kaw, LAS float* dst  , int kg, int vq) {
    float k[8], a[8], m[8], r[8], v[8];
    unpack8(w.k, k); unpack8(w.a, a); unpack8(w.m, m); unpack8(w.r, r); unpack8(w.v, v);
    if (VRES) { float vf[8], vg[8]; unpack8(w.vf, vf); unpack8(w.vg, vg);
#pragma unroll
        for (int j = 0; j < 8; ++j) v[j] = v[j] + (vf[j] - v[j]) * vg[j]; }
    float kk[8], ss = 0.f;
#pragma unroll
    for (int j = 0; j < 8; ++j) { kk[j] = k[j] * kkw[j]; ss += kk[j] * kk[j]; }
    ss = red8(ss);
    const float rn = rsqrtf(fmaxf(ss, 1e-24f));
    float o0[8], o1[8], o2[8];
#pragma unroll
    for (int j = 0; j < 8; ++j) { kk[j] *= rn; o0[j] = __expf(-m[j]); o1[j] = k[j] * (1.0f + (a[j] - 1.0f) * kaw[j]); o2[j] = kk[j] * a[j]; }
    LAS float* d8 = dst + kg * 8;
    *(LAS f32x4*)(d8 + 0 * 64) = (f32x4){o0[0], o0[1], o0[2], o0[3]}; *(LAS f32x4*)(d8 + 0 * 64 + 4) = (f32x4){o0[4], o0[5], o0[6], o0[7]};
    *(LAS f32x4*)(d8 + 1 * 64) = (f32x4){o1[0], o1[1], o1[2], o1[3]}; *(LAS f32x4*)(d8 + 1 * 64 + 4) = (f32x4){o1[4], o1[5], o1[6], o1[7]};
    *(LAS f32x4*)(d8 + 2 * 64) = (f32x4){o2[0], o2[1], o2[2], o2[3]}; *(LAS f32x4*)(d8 + 2 * 64 + 4) = (f32x4){o2[4], o2[5], o2[6], o2[7]};
    *(LAS f32x4*)(d8 + 3 * 64) = (f32x4){kk[0], kk[1], kk[2], kk[3]}; *(LAS f32x4*)(d8 + 3 * 64 + 4) = (f32x4){kk[4], kk[5], kk[6], kk[7]};
    *(LAS f32x4*)(d8 + 4 * 64) = (f32x4){r[0], r[1], r[2], r[3]};     *(LAS f32x4*)(d8 + 4 * 64 + 4) = (f32x4){r[4], r[5], r[6], r[7]};
    if (kg == vq) { LAS float* dv = dst + 320; *(LAS f32x4*)(dv) = (f32x4){v[0], v[1], v[2], v[3]}; *(LAS f32x4*)(dv + 4) = (f32x4){v[4], v[5], v[6], v[7]}; }
}
DI void scan_yreduce(const ScanA& A, const LAS float* yb, int dir, int head, int vq, int cc, int pt) {
    if (A.last && cc < CL / SC_CH) return;
    {
        const int q = pt, step = q >> 3, rowi = q & 7;
        const LAS float* src = yb + step * 128 + (rowi >> 2) * 64 + (rowi & 3) * 16;
        const f32x4 a0 = *(const LAS f32x4*)(src), a1 = *(const LAS f32x4*)(src + 4), a2 = *(const LAS f32x4*)(src + 8), a3 = *(const LAS f32x4*)(src + 12);
        const f32x4 t = (a0 + a1) + (a2 + a3);
        const float y = (t[0] + t[1]) + (t[2] + t[3]);
        const int row = scan_row(dir, cc * SC_CH + step);
        float* yp = dir == 0 ? A.y0 + (size_t)row * D : (row < T ? A.y1x + (size_t)row * D : A.y1c + (size_t)(row - T) * D);
        yp[head * 64 + vq * 8 + rowi] = y;
    }
}
#define SC_BAR() do { asm volatile("s_waitcnt lgkmcnt(0)" ::: "memory"); __builtin_amdgcn_s_barrier(); asm volatile("" ::: "memory"); } while (0)
template <bool VRES> DI void scan_phase(LAS unsigned char* lds, const ScanA& A) {
    if (blockIdx.x >= 256) return;
    const int wid = __builtin_amdgcn_readfirstlane(otid() >> 6);
    const int hd = blockIdx.x >> 3, head = hd & 15, dir = hd >> 4, vq = blockIdx.x & 7;
    LAS float* buf = (LAS float*)lds;
    LAS float* ybuf = buf + 2 * SC_BUF;
    constexpr int NCH = M / SC_CH;
    if (wid >= 4) {
        const int pt = otid() - 256, kg = pt & 7, stp = pt >> 3;
        float kkw[8], kaw[8];
#pragma unroll
        for (int j = 0; j < 8; ++j) { kkw[j] = A.kk_w[head * 64 + kg * 8 + j]; kaw[j] = A.ka_w[head * 64 + kg * 8 + j]; }
        ScanRaw S0, S1, S2;
        scan_load<VRES>(A, dir, head, 0, pt, S0);
        scan_prep<VRES>(A, S0, kkw, kaw, buf + stp * SC_STEP, kg, vq);
        scan_load<VRES>(A, dir, head, 1, pt, S1); scan_load<VRES>(A, dir, head, 2, pt, S2); scan_load<VRES>(A, dir, head, 3, pt, S0);
        SC_BAR();
#define SC_IT(c_, SET) do { const int c__ = (c_); \
            scan_prep<VRES>(A, SET, kkw, kaw, buf + ((c__ + 1) & 1) * SC_BUF + stp * SC_STEP, kg, vq); \
            scan_load<VRES>(A, dir, head, c__ + 4 < NCH ? c__ + 4 : NCH - 1, pt, SET); \
            if (c__ >= 1) scan_yreduce(A, ybuf + ((c__ - 1) & 1) * SC_YBUF, dir, head, vq, c__ - 1, pt); \
            SC_BAR(); } while (0)
        int c = 0;
        for (; c + 2 <= NCH; c += 3) { SC_IT(c, S1); SC_IT(c + 1, S2); SC_IT(c + 2, S0); }
        SC_IT(c, S1); SC_IT(c + 1, S2);
#undef SC_IT
    } else {
        const int lane = otid() & 63, vi = lane >> 4, kp = lane & 15;
        f32x2 sa = (f32x2){0.f, 0.f}, sb = (f32x2){0.f, 0.f};
        __builtin_amdgcn_s_setprio(2);
        SC_BAR();
        for (int c = 0; c <= NCH; ++c) {
            if (c < NCH && wid < 2) {
                const LAS float* b = buf + (c & 1) * SC_BUF + kp * 4;
                const LAS float* bv = buf + (c & 1) * SC_BUF + 320 + wid * 4 + vi;
                LAS float* yo = ybuf + (c & 1) * SC_YBUF + wid * 64 + lane;
                f32x4 w4 = *(const LAS f32x4*)(b + 0 * 64), kd4 = *(const LAS f32x4*)(b + 1 * 64), ka4 = *(const LAS f32x4*)(b + 2 * 64), kk4 = *(const LAS f32x4*)(b + 3 * 64), r4 = *(const LAS f32x4*)(b + 4 * 64);
                float vv = bv[0];
#pragma unroll
                for (int i = 0; i < SC_CH; ++i) {
                    const int in = i + 1 < SC_CH ? i + 1 : i;
                    const f32x4 nw4 = *(const LAS f32x4*)(b + in * SC_STEP + 0 * 64), nkd4 = *(const LAS f32x4*)(b + in * SC_STEP + 1 * 64), nka4 = *(const LAS f32x4*)(b + in * SC_STEP + 2 * 64),
                                nkk4 = *(const LAS f32x4*)(b + in * SC_STEP + 3 * 64), nr4 = *(const LAS f32x4*)(b + in * SC_STEP + 4 * 64);
                    const float nvv = bv[in * SC_STEP];
                    f32x2 t = sa * (f32x2){kk4[0], kk4[1]};
                    t = sb * (f32x2){kk4[2], kk4[3]} + t;
                    float d = t[0] + t[1];
                    d = red16(d);
                    sa = sa * (f32x2){w4[0], w4[1]} + (f32x2){kd4[0], kd4[1]} * vv;
                    sb = sb * (f32x2){w4[2], w4[3]} + (f32x2){kd4[2], kd4[3]} * vv;
                    sa = sa - (f32x2){ka4[0], ka4[1]} * d;
                    sb = sb - (f32x2){ka4[2], ka4[3]} * d;
                    f32x2 u = sa * (f32x2){r4[0], r4[1]};
                    u = sb * (f32x2){r4[2], r4[3]} + u;
                    yo[i * 128] = u[0] + u[1];
                    w4 = nw4; kd4 = nkd4; ka4 = nka4; kk4 = nkk4; r4 = nr4; vv = nvv;
                }
            }
            SC_BAR();
        }
        __builtin_amdgcn_s_setprio(0);
    }
}

DI void rwkv_readout(const Ctx& p, int j, int nrows, const ScanA& A, const bf16_t* Gg, bf16_t* O) {
    const int tid_ = otid(); const int NW = gridDim.x * 8, gw = blockIdx.x * 8 + (tid_ >> 6), lane = tid_ & 63;
    const int c0 = lane * 16;
    const float* lnw = p.in(30) + (size_t)j * D + c0; const float* lnb = p.in(31) + (size_t)j * D + c0; const float* rk = p.in(29) + (size_t)j * D + c0;
    for (int r = gw; r < nrows; r += NW) {
        const size_t off = (size_t)r * D + c0;
        float kf[16], rr[16], vv[16], o[16];
        unpack8(*(const u32x4*)(A.K + off), kf); unpack8(*(const u32x4*)(A.K + off + 8), kf + 8);
        unpack8(*(const u32x4*)(A.R + off), rr); unpack8(*(const u32x4*)(A.R + off + 8), rr + 8);
        unpack8(*(const u32x4*)(A.V + off), vv); unpack8(*(const u32x4*)(A.V + off + 8), vv + 8);
        if (A.vres) { float vf[16], vg[16];
            unpack8(*(const u32x4*)(A.VF + off), vf); unpack8(*(const u32x4*)(A.VF + off + 8), vf + 8);
            unpack8(*(const u32x4*)(A.VG + off), vg); unpack8(*(const u32x4*)(A.VG + off + 8), vg + 8);
#pragma unroll
            for (int q = 0; q < 16; ++q) vv[q] = vv[q] + (vf[q] - vv[q]) * vg[q]; }
#pragma unroll
        for (int q = 0; q < 16; ++q) o[q] = 0.f;
#pragma unroll
        for (int d = 0; d < 2; ++d) {
            const float* yp = d == 0 ? A.y0 + off : (r < T ? A.y1x + off : A.y1c + (size_t)(r - T) * D + c0);
            float y[16], a[16];
#pragma unroll
            for (int q = 0; q < 4; ++q) { const f32x4 t = *(const f32x4*)(yp + q * 4); y[q * 4] = t[0]; y[q * 4 + 1] = t[1]; y[q * 4 + 2] = t[2]; y[q * 4 + 3] = t[3]; }
            { const bf16_t* ap = d ? A.Aa1 : A.Aa0; unpack8(*(const u32x4*)(ap + off), a); unpack8(*(const u32x4*)(ap + off + 8), a + 8); }
            float sm = 0.f;
#pragma unroll
            for (int q = 0; q < 16; ++q) sm += y[q];
            sm += __shfl_xor(sm, 1); sm += __shfl_xor(sm, 2);
            const float mean = sm * (1.0f / 64.0f);
            float vs = 0.f, dot = 0.f;
#pragma unroll
            for (int q = 0; q < 16; ++q) { const float t = y[q] - mean; vs += t * t; const float kd = kf[q] * (1.0f + (a[q] - 1.0f) * p.in(28)[(size_t)j * D + c0 + q]); dot += rr[q] * kd * rk[q]; }
            vs += __shfl_xor(vs, 1); vs += __shfl_xor(vs, 2);
            dot += __shfl_xor(dot, 1); dot += __shfl_xor(dot, 2);
            const float rstd = rsqrtf(vs * (1.0f / 64.0f) + 64e-5f);
#pragma unroll
            for (int q = 0; q < 16; ++q) o[q] += (y[q] - mean) * rstd * lnw[q] + lnb[q] + dot * vv[q];
        }
        float g[16];
        unpack8(*(const u32x4*)(Gg + off), g); unpack8(*(const u32x4*)(Gg + off + 8), g + 8);
        u32x4 w0, w1;
        w0.x = cvt_pk_bf16(o[0] * g[0], o[1] * g[1]); w0.y = cvt_pk_bf16(o[2] * g[2], o[3] * g[3]); w0.z = cvt_pk_bf16(o[4] * g[4], o[5] * g[5]); w0.w = cvt_pk_bf16(o[6] * g[6], o[7] * g[7]);
        w1.x = cvt_pk_bf16(o[8] * g[8], o[9] * g[9]); w1.y = cvt_pk_bf16(o[10] * g[10], o[11] * g[11]); w1.z = cvt_pk_bf16(o[12] * g[12], o[13] * g[13]); w1.w = cvt_pk_bf16(o[14] * g[14], o[15] * g[15]);
        *(u32x4*)(O + off) = w0; *(u32x4*)(O + off + 8) = w1;
    }
}

DI float rope_inv(int j) { return exp2f(-(float)j * 1.6609640474436813f); }
DI void mla_norms(const Ctx& p) {
    const int tid_ = otid(); const int NW = gridDim.x * 8, gw = blockIdx.x * 8 + (tid_ >> 6), lane = tid_ & 63;
    const float* C = (const float*)(p.ws() + OFF_Y);
    bf16_t* CQN = (bf16_t*)(p.ws() + OFF_CQN); bf16_t* CKVN = (bf16_t*)(p.ws() + OFF_CKVN); float* KR = (float*)(p.ws() + OFF_KR);
    for (int r = gw; r < M; r += NW) {
        const float* c = C + (size_t)r * 768;
        float q[6], ss = 0.f;
#pragma unroll
        for (int u = 0; u < 6; ++u) { q[u] = c[u * 64 + lane]; ss += q[u] * q[u]; }
        ss = wave_sum(ss);
        float rs = rsqrtf(ss * (1.0f / 384.0f) + EPS);
#pragma unroll
        for (int u = 0; u < 6; ++u) CQN[(size_t)r * 384 + u * 64 + lane] = f2bf(q[u] * rs * p.in(33)[u * 64 + lane]);
        float kv[4]; ss = 0.f;
#pragma unroll
        for (int u = 0; u < 4; ++u) { kv[u] = c[384 + u * 64 + lane]; ss += kv[u] * kv[u]; }
        ss = wave_sum(ss);
        rs = rsqrtf(ss * (1.0f / 256.0f) + EPS);
#pragma unroll
        for (int u = 0; u < 4; ++u) CKVN[(size_t)r * 256 + u * 64 + lane] = f2bf(kv[u] * rs * p.in(36)[u * 64 + lane]);
        const int d = lane & 31;
        const float v = c[640 + d];
        const float pr = __shfl_xor(v, 8);
        float o = v;
        if (r < T) {
            const int axis = d >> 4, jj = d & 15;
            const float pos = axis ? (float)(r & 63) : (float)(r >> 6);
            const float ang = pos * rope_inv(jj & 7);
            const float cs = cosf(ang), sn = sinf(ang);
            o = jj < 8 ? v * cs - pr * sn : pr * sn + v * cs;
        }
        if (lane < 32) KR[(size_t)r * 32 + d] = o;
    }
}
DI void mla_pack(const Ctx& p) {
    const int tid_ = otid(); const int NW = gridDim.x * 8, gw = blockIdx.x * 8 + (tid_ >> 6), lane = tid_ & 63;
    bf16_t* Q = (bf16_t*)(p.ws() + OFF_Q); const bf16_t* KV = (const bf16_t*)(p.ws() + OFF_KV); const float* KR = (const float*)(p.ws() + OFF_KR);
    bf16_t* KP = (bf16_t*)(p.ws() + OFF_KP); bf16_t* VT = (bf16_t*)(p.ws() + OFF_VT);
    const float qs = 0.10206207261596577f * 1.4426950408889634f;
    for (int r = gw; r < M; r += NW) {
        bf16_t* q = Q + (size_t)r * 1536; const bf16_t* kv = KV + (size_t)r * 2048; bf16_t* kp = KP + (size_t)r * 1536;
#pragma unroll 4
        for (int e = lane; e < 1024; e += 64) { const int h = e >> 6, d = e & 63; q[h * 96 + d] = f2bf(bf2f(q[h * 96 + d]) * qs); kp[h * 96 + d] = kv[h * 128 + d]; }
#pragma unroll 4
        for (int e = lane; e < 512; e += 64) { const int h = e >> 5, d = e & 31; kp[h * 96 + 64 + d] = f2bf(KR[(size_t)r * 32 + d]); }
        for (int pi = lane; pi < 256; pi += 64) {
            const int h = pi >> 4, axis = (pi >> 3) & 1, jj = pi & 7;
            bf16_t* a = q + h * 96 + 64 + axis * 16 + jj;
            const float x1 = bf2f(a[0]), x2 = bf2f(a[8]);
            float o1 = x1, o2 = x2;
            if (r < T) { const float pos = axis ? (float)(r & 63) : (float)(r >> 6); const float ang = pos * rope_inv(jj); const float cs = cosf(ang), sn = sinf(ang); o1 = x1 * cs - x2 * sn; o2 = x1 * sn + x2 * cs; }
            a[0] = f2bf(o1 * qs); a[8] = f2bf(o2 * qs);
        }
    }
    for (int it = gw; it < (M / 64) * 16; it += NW) {
        const int rb = it >> 4, h = it & 15, r0 = rb * 64;
        const bf16_t* src = KV + (size_t)r0 * 2048 + h * 128 + 64 + lane;
        bf16_t* dst = VT + (size_t)(h * 64 + lane) * M + r0;
#pragma unroll
        for (int g = 0; g < 8; ++g) {
            unsigned short v[8];
#pragma unroll
            for (int u = 0; u < 8; ++u) v[u] = src[(size_t)(g * 8 + u) * 2048];
            u32x4 w; w.x = v[0] | ((unsigned)v[1] << 16); w.y = v[2] | ((unsigned)v[3] << 16); w.z = v[4] | ((unsigned)v[5] << 16); w.w = v[6] | ((unsigned)v[7] << 16);
            *(u32x4*)(dst + g * 8) = w;
        }
    }
}

constexpr int AT_KS = 104, AT_VS = 68;
constexpr int AT_KBYTES = 64 * AT_KS * 2, AT_VBYTES = 64 * AT_VS * 2, AT_BUF = AT_KBYTES + AT_VBYTES;
DI bf16x8 pack_p(const f32x16& x, int s) {
    u32x4 pk;
    asm volatile("s_nop 1\n\tv_cvt_pk_bf16_f32 %0, %4, %5\n\tv_cvt_pk_bf16_f32 %1, %6, %7\n\tv_cvt_pk_bf16_f32 %2, %8, %9\n\tv_cvt_pk_bf16_f32 %3, %10, %11\n\ts_nop 1"
                 : "=&v"(pk[0]), "=&v"(pk[1]), "=&v"(pk[2]), "=&v"(pk[3])
                 : "v"(x[8 * s]), "v"(x[8 * s + 1]), "v"(x[8 * s + 2]), "v"(x[8 * s + 3]), "v"(x[8 * s + 4]), "v"(x[8 * s + 5]), "v"(x[8 * s + 6]), "v"(x[8 * s + 7]));
    return __builtin_bit_cast(bf16x8, pk);
}
DI void attn_phase(LAS unsigned char* lds, const Ctx& p) {
    const bf16_t* Qp = (const bf16_t*)(p.ws() + OFF_Q); const bf16_t* Kp = (const bf16_t*)(p.ws() + OFF_KP); const bf16_t* Vt = (const bf16_t*)(p.ws() + OFF_VT);
    bf16_t* AO = (bf16_t*)(p.ws() + OFF_H);
    const int tid = otid(), wid = tid >> 6, lane = tid & 63, l31 = lane & 31, hl = lane >> 5;
    for (int it = blockIdx.x; it < 1040; it += gridDim.x) {
        int h, qb;
        if (it < 1024) { const int rnd = it >> 8, bb = it & 255; h = (bb & 7) + 8 * (rnd & 1); qb = (bb >> 3) + 32 * (rnd >> 1); }
        else { h = it - 1024; qb = 64; }
        const int kb = qb == 64 ? T : 0, ntile = qb == 64 ? CL / 64 : M / 64;
        const int qrow = qb * 256 + wid * 32 + l31;
        bf16x8 qf[6];
#pragma unroll
        for (int st = 0; st < 6; ++st) qf[st] = *(const bf16x8*)(Qp + (size_t)qrow * 1536 + h * 96 + st * 16 + hl * 8);
        f32x16 o0, o1;
#pragma unroll
        for (int i = 0; i < 16; ++i) { o0[i] = 0.f; o1[i] = 0.f; }
        float mrun = 0.f, lsum = 0.f;
        f32x16 negm;
#pragma unroll
        for (int i = 0; i < 16; ++i) negm[i] = 0.f;
        const int kr0 = tid / 12, kc0 = tid % 12, kr1 = (tid + 512) / 12, kc1 = (tid + 512) % 12, vd = tid >> 3, vc = tid & 7;
        u32x4 gk0, gk1 = (u32x4){0u, 0u, 0u, 0u}, gv;
        {
            gk0 = *(const u32x4*)(Kp + (size_t)(kb + kr0) * 1536 + h * 96 + kc0 * 8);
            if (tid < 256) gk1 = *(const u32x4*)(Kp + (size_t)(kb + kr1) * 1536 + h * 96 + kc1 * 8);
            gv = *(const u32x4*)(Vt + (size_t)(h * 64 + vd) * M + kb + vc * 8);
            LAS unsigned char* b = lds;
            *(LAS u32x4*)(b + (kr0 * AT_KS + kc0 * 8) * 2) = gk0;
            if (tid < 256) *(LAS u32x4*)(b + (kr1 * AT_KS + kc1 * 8) * 2) = gk1;
            *(LAS u32x2*)(b + AT_KBYTES + (vd * AT_VS + vc * 8) * 2) = (u32x2){gv.x, gv.y};
            *(LAS u32x2*)(b + AT_KBYTES + (vd * AT_VS + vc * 8) * 2 + 8) = (u32x2){gv.z, gv.w};
        }
        __syncthreads();
        if (__builtin_amdgcn_readfirstlane(tid) >= 256) __builtin_amdgcn_s_setprio(1);
        for (int j = 0; j < ntile; ++j) {
            const bool more = j + 1 < ntile;
            if (more) {
                const int k0 = kb + (j + 1) * 64;
                gk0 = *(const u32x4*)(Kp + (size_t)(k0 + kr0) * 1536 + h * 96 + kc0 * 8);
                if (tid < 256) gk1 = *(const u32x4*)(Kp + (size_t)(k0 + kr1) * 1536 + h * 96 + kc1 * 8);
                gv = *(const u32x4*)(Vt + (size_t)(h * 64 + vd) * M + k0 + vc * 8);
            }
            const LAS unsigned char* kb_ = lds + (j & 1) * AT_BUF;
            const LAS unsigned char* vb_ = kb_ + AT_KBYTES;
            f32x16 s0, s1;
            {
                const bf16x8 a0 = *(const LAS bf16x8*)(kb_ + (l31 * AT_KS + hl * 8) * 2);
                const bf16x8 a1 = *(const LAS bf16x8*)(kb_ + ((32 + l31) * AT_KS + hl * 8) * 2);
                s0 = __builtin_amdgcn_mfma_f32_32x32x16_bf16(a0, qf[0], negm, 0, 0, 0);
                s1 = __builtin_amdgcn_mfma_f32_32x32x16_bf16(a1, qf[0], negm, 0, 0, 0);
            }
#pragma unroll
            for (int st = 1; st < 6; ++st) {
                const bf16x8 a0 = *(const LAS bf16x8*)(kb_ + (l31 * AT_KS + st * 16 + hl * 8) * 2);
                const bf16x8 a1 = *(const LAS bf16x8*)(kb_ + ((32 + l31) * AT_KS + st * 16 + hl * 8) * 2);
                s0 = __builtin_amdgcn_mfma_f32_32x32x16_bf16(a0, qf[st], s0, 0, 0, 0);
                s1 = __builtin_amdgcn_mfma_f32_32x32x16_bf16(a1, qf[st], s1, 0, 0, 0);
            }
            float mx = s0[0];
#pragma unroll
            for (int i = 1; i < 16; ++i) mx = fmaxf(mx, s0[i]);
#pragma unroll
            for (int i = 0; i < 16; ++i) mx = fmaxf(mx, s1[i]);
            mx = fmaxf(mx, __shfl_xor(mx, 32));
            if (__builtin_amdgcn_ballot_w64(mx > 8.0f) != 0ull) {
                const float delta = mx > 8.0f ? mx : 0.f;
                const float alpha = __builtin_amdgcn_exp2f(-delta);
                mrun += delta; lsum *= alpha;
#pragma unroll
                for (int i = 0; i < 16; ++i) { s0[i] -= delta; s1[i] -= delta; o0[i] *= alpha; o1[i] *= alpha; negm[i] = -mrun; }
            }
            float ps = 0.f;
#pragma unroll
            for (int i = 0; i < 16; ++i) { s0[i] = __builtin_amdgcn_exp2f(s0[i]); s1[i] = __builtin_amdgcn_exp2f(s1[i]); ps += s0[i] + s1[i]; }
            lsum += ps;
#pragma unroll
            for (int kt = 0; kt < 2; ++kt)
#pragma unroll
                for (int s = 0; s < 2; ++s) {
                    const bf16x8 pf = pack_p(kt ? s1 : s0, s);
                    const int kbase = kt * 32 + s * 16 + 4 * hl;
                    const u32x2 va0 = *(const LAS u32x2*)(vb_ + (l31 * AT_VS + kbase) * 2), va1 = *(const LAS u32x2*)(vb_ + (l31 * AT_VS + kbase + 8) * 2);
                    const u32x2 vb0 = *(const LAS u32x2*)(vb_ + ((32 + l31) * AT_VS + kbase) * 2), vb1 = *(const LAS u32x2*)(vb_ + ((32 + l31) * AT_VS + kbase + 8) * 2);
                    const bf16x8 vfa = __builtin_bit_cast(bf16x8, (u32x4){va0.x, va0.y, va1.x, va1.y});
                    const bf16x8 vfb = __builtin_bit_cast(bf16x8, (u32x4){vb0.x, vb0.y, vb1.x, vb1.y});
                    o0 = __builtin_amdgcn_mfma_f32_32x32x16_bf16(vfa, pf, o0, 0, 0, 0);
                    o1 = __builtin_amdgcn_mfma_f32_32x32x16_bf16(vfb, pf, o1, 0, 0, 0);
                }
            if (more) {
                LAS unsigned char* b = lds + ((j + 1) & 1) * AT_BUF;
                *(LAS u32x4*)(b + (kr0 * AT_KS + kc0 * 8) * 2) = gk0;
                if (tid < 256) *(LAS u32x4*)(b + (kr1 * AT_KS + kc1 * 8) * 2) = gk1;
                *(LAS u32x2*)(b + AT_KBYTES + (vd * AT_VS + vc * 8) * 2) = (u32x2){gv.x, gv.y};
                *(LAS u32x2*)(b + AT_KBYTES + (vd * AT_VS + vc * 8) * 2 + 8) = (u32x2){gv.z, gv.w};
            }
            __syncthreads();
        }
        __builtin_amdgcn_s_setprio(0);
        const float ltot = lsum + __shfl_xor(lsum, 32);
        const float inv = 1.0f / ltot;
        bf16_t* op = AO + (size_t)qrow * D + h * 64 + 4 * hl;
#pragma unroll
        for (int g = 0; g < 4; ++g) {
            u32x2 w; w.x = cvt_pk_bf16(o0[4 * g] * inv, o0[4 * g + 1] * inv); w.y = cvt_pk_bf16(o0[4 * g + 2] * inv, o0[4 * g + 3] * inv);
            *(u32x2*)(op + 8 * g) = w;
            u32x2 w2; w2.x = cvt_pk_bf16(o1[4 * g] * inv, o1[4 * g + 1] * inv); w2.y = cvt_pk_bf16(o1[4 * g + 2] * inv, o1[4 * g + 3] * inv);
            *(u32x2*)(op + 32 + 8 * g) = w2;
        }
    }
}

DI void pool_diff(const Ctx& p) {
    const int tid_ = otid(); const int NW = gridDim.x * 8, gw = blockIdx.x * 8 + (tid_ >> 6), lane = tid_ & 63;
    const float* Hf = (const float*)(p.ws() + OFF_Y); bf16_t* Dd = (bf16_t*)(p.ws() + OFF_H);
    for (int r = gw; r < M; r += NW) {
        const int base = r >= T ? T : 0, len = r >= T ? CL : T, t = r - base;
#pragma unroll
        for (int i = 0; i < 4; ++i) {
            const int half = 1 << i, c = i * 256 + lane * 4;
            int lo = t - half, hi = t + half; lo = lo < 0 ? 0 : lo; hi = hi > len ? len : hi;
            f32x4 sum = (f32x4){0.f, 0.f, 0.f, 0.f};
            for (int u = lo; u < hi; ++u) sum += *(const f32x4*)(Hf + (size_t)(base + u) * D + c);
            const f32x4 h = *(const f32x4*)(Hf + (size_t)r * D + c);
            const f32x4 df = sum * (1.0f / (float)(hi - lo)) - h;
            u32x2 w; w.x = cvt_pk_bf16(df[0], df[1]); w.y = cvt_pk_bf16(df[2], df[3]);
            *(u32x2*)(Dd + (size_t)r * D + c) = w;
        }
    }
}

__global__ void __launch_bounds__(NT) mega(Params kp) {
    extern __shared__ __attribute__((aligned(16))) unsigned char lds_raw[];
    LAS unsigned char* lds = (LAS unsigned char*)lds_raw;
    cg::grid_group grid = cg::this_grid();
    constexpr int LDS_MAIN_ = SC_LDS_BYTES > pg8::STAGE_BYTES ? SC_LDS_BYTES : pg8::STAGE_BYTES;
    { LAS unsigned* tw = (LAS unsigned*)(lds + LDS_MAIN_ + 64); if (threadIdx.x < 88) tw[threadIdx.x] = ((const unsigned*)&kp)[threadIdx.x]; }
    Ctx p; p.tab = (const LAS unsigned*)(lds + LDS_MAIN_ + 64);
    volatile LAS unsigned* bst = (volatile LAS unsigned*)(lds + (SC_LDS_BYTES > pg8::STAGE_BYTES ? SC_LDS_BYTES : pg8::STAGE_BYTES));
    if (threadIdx.x < 2) bst[threadIdx.x] = 0u;
    __syncthreads();
    const XcdBarrier xbar = xcd_barrier_post((unsigned*)(p.ws() + OFF_BAR), bst);
#define GSYNC() xcd_barrier(xbar)
    __syncthreads();
    unsigned char* ws = p.ws();
    bf16_t* H = (bf16_t*)(ws + OFF_H); float* Y = (float*)(ws + OFF_Y); bf16_t* ACT = (bf16_t*)(ws + OFF_X);

    { mod_phase(p, lds); int rot = 0; conv_mixers(p, rot); conv_ffn(p, 0, rot); }
    grid.sync();
    post_pre(p, 0, -1, 0.f, 0, 0, M, false, false, false);
    GSYNC();

    for (int i = 0; i < DEPTH; ++i) {
        const int kind = i % 3, j = i / 3;
        const bool last = i == DEPTH - 1;
        int used = 0;
        { pg8::EpiSwiglu E{ACT}; run_gemm(lds, H, D, (const bf16_t*)(ws + OFF_FFN), D, M, 2 * FF, D, E, used); }
        GSYNC();
        ffn_down(lds, p, ACT, (const bf16_t*)(ws + OFF_FFN + SZ_FFN1), Y, true, used);
        GSYNC();
        post_pre(p, i, 0, 0.5f, i, 1, M, kind != 1, false, true);
        GSYNC();
        if (kind == 0) {
            unsigned char* wb = ws + OFF_RWB + j * SZ_RWB;
            bf16_t* X = (bf16_t*)(ws + OFF_X);
            bf16_t* Rb = (bf16_t*)(ws + OFF_RKV); bf16_t* Kb = Rb + (size_t)M * D; bf16_t* Vb = j == 0 ? (bf16_t*)(ws + OFF_VF) : Kb + (size_t)M * D;
            bf16_t* L1a = H; bf16_t* L1b = H + (size_t)M * 256;
            rwkv_mix(p, j);
            GSYNC();
            {
                pg8::EpiB Er{Rb, D, 0, D, 0, nullptr, nullptr, 0}; run_gemm(lds, X + 0 * (size_t)M * D, D, (const bf16_t*)(wb + RWB_WR), D, M, D, D, Er, used);
                pg8::EpiB Ek{Kb, D, 0, D, 0, nullptr, nullptr, 0}; run_gemm(lds, X + 2 * (size_t)M * D, D, (const bf16_t*)(wb + RWB_WK), D, M, D, D, Ek, used);
                pg8::EpiB Ev{Vb, D, 0, D, 0, nullptr, nullptr, 0}; run_gemm(lds, X + 3 * (size_t)M * D, D, (const bf16_t*)(wb + RWB_WV), D, M, D, D, Ev, used);
                pg8::EpiB Ew{L1a, 256, 0, 128, 1, nullptr, nullptr, 0}; run_gemm(lds, X + 1 * (size_t)M * D, D, (const bf16_t*)(wb + RWB_W1W), D, M, 256, D, Ew, used);
                pg8::EpiB Ea{L1a, 256, 128, 128, 0, nullptr, nullptr, 0}; run_gemm(lds, X + 4 * (size_t)M * D, D, (const bf16_t*)(wb + RWB_W1A), D, M, 256, D, Ea, used);
                pg8::EpiB Eg{L1b, 256, 0, 160, 2, nullptr, nullptr, 0}; run_gemm(lds, X + 5 * (size_t)M * D, D, (const bf16_t*)(wb + RWB_W1G), D, M, 256, D, Eg, used);
                if (j == 1) { pg8::EpiB Ex{L1b, 256, 160, 96, 0, nullptr, nullptr, 0}; run_gemm(lds, X + 3 * (size_t)M * D, D, (const bf16_t*)(wb + RWB_W1V), D, M, 256, D, Ex, used); }
            }
            GSYNC();
            {
                pg8::EpiB E2a{X, D, 0, 4096, 3, p.in(16) + (size_t)j * 2 * D, p.in(19) + (size_t)j * 2 * D, (size_t)M * D};
                run_gemm(lds, L1a, 256, (const bf16_t*)(wb + RWB_W2A), 256, M, 4096, 256, E2a, used);
                pg8::EpiB E2b{X, D, 0, j == 1 ? 2048 : 1024, 4, nullptr, p.in(22), (size_t)M * D};
                run_gemm(lds, L1b, 256, (const bf16_t*)(wb + RWB_W2B), 256, M, j == 1 ? 2048 : 1024, 256, E2b, used);
            }
            GSYNC();
            ScanA A;
            A.R = Rb; A.K = Kb; A.V = Vb; A.VF = (const bf16_t*)(ws + OFF_VF); A.VG = X + 5 * (size_t)M * D;
            A.Mw0 = X; A.Mw1 = X + (size_t)M * D; A.Aa0 = X + 2 * (size_t)M * D; A.Aa1 = X + 3 * (size_t)M * D;
            A.kk_w = p.in(27) + (size_t)j * D; A.ka_w = p.in(28) + (size_t)j * D;
            A.y0 = Y; A.y1x = p.out(); A.y1c = (float*)(ws + OFF_Y1C); A.vres = j == 1; A.last = last;
            if (j == 1) scan_phase<true>(lds, A); else scan_phase<false>(lds, A);
            GSYNC();
            const int mrows = last ? T : M;
            rwkv_readout(p, j, mrows, A, X + 4 * (size_t)M * D, H);
            GSYNC();
            { pg8::EpiF32 E{Y, D}; run_gemm(lds, H, D, (const bf16_t*)(wb + RWB_WO), D, mrows, D, D, E, used); }
        } else if (kind == 1) {
            const bf16_t* wd = (const bf16_t*)(ws + OFF_MLA); const bf16_t* wuq = (const bf16_t*)(ws + OFF_MLA + SZ_WD);
            const bf16_t* wukv = (const bf16_t*)(ws + OFF_MLA + SZ_WD + SZ_WUQ); const bf16_t* wo = (const bf16_t*)(ws + OFF_MLA + SZ_WD + SZ_WUQ + SZ_WUKV);
            { pg8::EpiF32 E{Y, 768}; run_gemm(lds, H, D, wd, D, M, 768, D, E, used); }
            GSYNC();
            mla_norms(p);
            GSYNC();
            { pg8::EpiB Eq{(bf16_t*)(ws + OFF_Q), 1536, 0, 1536, 0, nullptr, nullptr, 0}; run_gemm(lds, (const bf16_t*)(ws + OFF_CQN), 384, wuq, 384, M, 1536, 384, Eq, used);
              pg8::EpiB Ekv{(bf16_t*)(ws + OFF_KV), 2048, 0, 2048, 0, nullptr, nullptr, 0}; run_gemm(lds, (const bf16_t*)(ws + OFF_CKVN), 256, wukv, 256, M, 2048, 256, Ekv, used); }
            GSYNC();
            mla_pack(p);
            GSYNC();
            attn_phase(lds, p);
            GSYNC();
            { pg8::EpiF32 E{Y, D}; run_gemm(lds, H, D, wo, D, M, D, D, E, used); }
        } else {
            pool_diff(p);
            GSYNC();
            { pg8::EpiPool E{Y, p.in(40) + (size_t)j * D, p.in(41) + (size_t)j * D}; run_gemm(lds, H, D, (const bf16_t*)(ws + OFF_POOLW), D, M, D, D, E, used); }
        }
        GSYNC();
        const int mrows = last ? T : M;
        post_pre(p, i, 1, 1.0f, i, 2, mrows, false, false, false);
        GSYNC();
        { pg8::EpiSwiglu E{ACT}; run_gemm(lds, H, D, (const bf16_t*)(ws + OFF_FFN + SZ_FFNS), D, mrows, 2 * FF, D, E, used); }
        GSYNC();
        ffn_down(lds, p, ACT, (const bf16_t*)(ws + OFF_FFN + SZ_FFNS + SZ_FFN1), Y, !last, used);
        GSYNC();
        if (!last) { post_pre(p, i, 2, 0.5f, i + 1, 0, M, false, false, true); int rot = 0; conv_ffn(p, i + 1, rot); }
        else post_pre(p, i, 2, 0.5f, 0, -1, T, false, true, false);
        if (!last) GSYNC();
    }
}

extern "C" void kernel_launch(void* const* d_in, const int* in_sizes, int n_in, void* d_out, int out_size, void* d_ws, size_t ws_size, hipStream_t stream) {
    static int grid_blocks = 0;
    constexpr int LDS_MAIN = SC_LDS_BYTES > pg8::STAGE_BYTES ? SC_LDS_BYTES : pg8::STAGE_BYTES;
    constexpr int LDS_BYTES = LDS_MAIN + 64 + 512;
    if (!grid_blocks) {
        if (n_in != 42 || ws_size < WS_TOTAL || out_size != T * D) { fprintf(stderr, "kernel_launch: unexpected problem (n_in %d ws %zu need %zu out %d)\n", n_in, ws_size, (size_t)WS_TOTAL, out_size); grid_blocks = -1; return; }
        int dev = 0, cus = 0, per_cu = 0;
        hipGetDevice(&dev);
        hipDeviceGetAttribute(&cus, hipDeviceAttributeMultiprocessorCount, dev);
        hipFuncSetAttribute((const void*)mega, hipFuncAttributeMaxDynamicSharedMemorySize, LDS_BYTES);
        hipOccupancyMaxActiveBlocksPerMultiprocessor(&per_cu, (const void*)mega, NT, LDS_BYTES);
        if (per_cu < 1) { fprintf(stderr, "kernel_launch: occupancy query says %d blocks per CU\n", per_cu); per_cu = 1; }
        grid_blocks = cus * per_cu;
        if (grid_blocks > 256) grid_blocks = 256;
    }
    if (grid_blocks < 0) return;
    if (hipMemsetAsync((unsigned char*)d_ws + OFF_BAR, 0, 16384, stream) != hipSuccess) { fprintf(stderr, "kernel_launch: memset failed\n"); return; }
    Params p{};
    for (int i = 0; i < 42; ++i) p.in[i] = (const float*)d_in[i];
    p.out = (float*)d_out; p.ws = (unsigned char*)d_ws;
    void* args[] = {&p};
    hipError_t e = hipLaunchCooperativeKernel((const void*)mega, dim3(grid_blocks), dim3(NT), args, LDS_BYTES, stream);
    if (e != hipSuccess) fprintf(stderr, "cooperative launch failed: %s (grid %d)\n", hipGetErrorString(e), grid_blocks);
}
```
